# Optimizing an MI355X kernel written in HIP

```python
import jax, jax.numpy as jnp
from jax import lax
import numpy as np

D_MODEL = 1024
BATCH = 1
SEQ = 16384
DEPTH = 2
DEC_BATCH = 16
DEC_SEQ = 2048
PAST_LEN = 128

D_RG = D_MODEL
RG_HEADS = 8
RG_HEAD_DIM = D_RG // RG_HEADS
RG_CONV = 4
RG_PAD_L = 2
RG_PAD_R = RG_CONV - 1 - RG_PAD_L
RG_C = 8.0
D_SG = D_MODEL // 2
SG_CHUNK = 128
SG_GROUPS = 4
SG_GROUP_DIM = D_SG // SG_GROUPS
D_CC = D_MODEL // 2
CC_KERNEL = 31
CC_PAD = (CC_KERNEL - 1) // 2
D_FF = 4 * D_MODEL
N_BRANCH = 3
OFF_RG_X = 0
OFF_RG_G = OFF_RG_X + D_RG
OFF_SG = OFF_RG_G + D_RG
OFF_CC = OFF_SG + 2 * D_SG
OFF_GATE = OFF_CC + 2 * D_CC
D_IN = OFF_GATE + N_BRANCH * D_MODEL
DEEPNORM_ALPHA = (2 * DEPTH) ** 0.25
DEEPNORM_BETA = (8 * DEPTH) ** -0.25
LN_EPS = 1e-5

kernel_name = "hybrid_rglru_sgu_conformer_encoder"


def _layer_norm(x, g, b):
    xf = x.astype(jnp.float32)
    mu = jnp.mean(xf, axis=-1, keepdims=True)
    var = jnp.mean(jnp.square(xf - mu), axis=-1, keepdims=True)
    y = (xf - mu) * lax.rsqrt(var + LN_EPS)
    return (y * g.astype(jnp.float32) + b.astype(jnp.float32)).astype(x.dtype)


def _depthwise_conv(x, w, b, pad_l, pad_r):
    c = x.shape[-1]
    y = lax.conv_general_dilated(x, w[:, None, :], window_strides=(1,), padding=[(pad_l, pad_r)],
                                 dimension_numbers=("NWC", "WIO", "NWC"), feature_group_count=c)
    return y + b


def _linear_scan(a, u):
    def combine(c1, c2):
        a1, b1 = c1
        a2, b2 = c2
        return a1 * a2, a2 * b1 + b2
    _, h = lax.associative_scan(combine, (a, u), axis=1)
    return h


def _rg_lru_direction(x, w_a, b_a, w_x, b_x, lam, reverse):
    if reverse:
        x = jnp.flip(x, axis=1)
    bn, s, _ = x.shape
    xh = x.reshape(bn, s, RG_HEADS, RG_HEAD_DIM)
    r = jax.nn.sigmoid(jnp.einsum("bshi,hio->bsho", xh, w_a) + b_a).reshape(bn, s, D_RG).astype(jnp.float32)
    i = jax.nn.sigmoid(jnp.einsum("bshi,hio->bsho", xh, w_x) + b_x).reshape(bn, s, D_RG)
    log_a = -RG_C * r * jax.nn.softplus(-lam.astype(jnp.float32))
    a = jnp.exp(log_a)
    u = jnp.sqrt(-jnp.expm1(2.0 * log_a)) * (i * x).astype(jnp.float32)
    h = _linear_scan(a, u)
    if reverse:
        h = jnp.flip(h, axis=1)
    return h.astype(x.dtype)


def _trunk(x, ln_in_g, ln_in_b, w_in, b_in, conv_a_w, conv_a_b, rg_wa, rg_ba, rg_wx, rg_bx, rg_lambda,
           sg_ln_g, sg_ln_b, sg_w, sg_b, conv_c_w, conv_c_b, cc_ln_g, cc_ln_b, w_ba, w_bb, w_bc,
           w_o, b_o, ln1_g, ln1_b, w_ff1, b_ff1, w_ff2, b_ff2, ln2_g, ln2_b):
    bn, s, _ = x.shape
    x = _layer_norm(x, ln_in_g, ln_in_b)
    for l in range(DEPTH):
        proj = x @ w_in[l] + b_in[l]
        xa = _depthwise_conv(proj[..., OFF_RG_X:OFF_RG_X + D_RG], conv_a_w[l], conv_a_b[l], RG_PAD_L, RG_PAD_R)
        h = (_rg_lru_direction(xa, rg_wa[l, 0], rg_ba[l, 0], rg_wx[l, 0], rg_bx[l, 0], rg_lambda[l, 0], False)
             + _rg_lru_direction(xa, rg_wa[l, 1], rg_ba[l, 1], rg_wx[l, 1], rg_bx[l, 1], rg_lambda[l, 1], True))
        y_a = (h * jax.nn.gelu(proj[..., OFF_RG_G:OFF_RG_G + D_RG])) @ w_ba[l]
        uv = jax.nn.gelu(proj[..., OFF_SG:OFF_SG + 2 * D_SG])
        u, v = uv[..., :D_SG], uv[..., D_SG:]
        v = _layer_norm(v, sg_ln_g[l], sg_ln_b[l])
        vc = v.reshape(bn, s // SG_CHUNK, SG_CHUNK, SG_GROUPS, SG_GROUP_DIM)
        sp = jnp.einsum("gpq,bcqgd->bcpgd", sg_w[l], vc) + sg_b[l].T[:, :, None]
        y_b = (u * sp.reshape(bn, s, D_SG)) @ w_bb[l]
        c = proj[..., OFF_CC:OFF_CC + D_CC] * jax.nn.sigmoid(proj[..., OFF_CC + D_CC:OFF_GATE])
        c = _depthwise_conv(c, conv_c_w[l], conv_c_b[l], CC_PAD, CC_PAD)
        c = jax.nn.silu(_layer_norm(c, cc_ln_g[l], cc_ln_b[l]))
        y_c = c @ w_bc[l]
        g = jax.nn.sigmoid(proj[..., OFF_GATE:])
        merged = (g[..., :D_MODEL] * y_a + g[..., D_MODEL:2 * D_MODEL] * y_b + g[..., 2 * D_MODEL:] * y_c)
        x = _layer_norm(DEEPNORM_ALPHA * x + merged @ w_o[l] + b_o[l], ln1_g[l], ln1_b[l])
        hid = jnp.square(jax.nn.relu(x @ w_ff1[l] + b_ff1[l]))
        x = _layer_norm(DEEPNORM_ALPHA * x + hid @ w_ff2[l] + b_ff2[l], ln2_g[l], ln2_b[l])
    return x


def setup_inputs(seed: int = 0) -> dict:
    key = jax.random.key(seed)
    ks = jax.random.split(key, 40)
    f32 = jnp.float32

    def nrm(k, shape, scale):
        return jax.random.normal(k, shape, f32) * scale

    a_c = jax.random.uniform(ks[12], (DEPTH, 2, D_RG), f32, 0.9, 0.999)
    a = a_c ** (1.0 / RG_C)
    return {
        "x_prompt": nrm(ks[0], (BATCH, SEQ, D_MODEL), 1.0),
        "x_sample": nrm(ks[1], (DEC_BATCH, DEC_SEQ, D_MODEL), 1.0),
        "ln_in_g": 1.0 + nrm(ks[2], (D_MODEL,), 0.02),
        "ln_in_b": nrm(ks[3], (D_MODEL,), 0.02),
        "w_in": nrm(ks[4], (DEPTH, D_MODEL, D_IN), D_MODEL ** -0.5),
        "b_in": nrm(ks[5], (DEPTH, D_IN), 0.02),
        "conv_a_w": nrm(ks[6], (DEPTH, RG_CONV, D_RG), RG_CONV ** -0.5),
        "conv_a_b": nrm(ks[7], (DEPTH, D_RG), 0.02),
        "rg_wa": nrm(ks[8], (DEPTH, 2, RG_HEADS, RG_HEAD_DIM, RG_HEAD_DIM), RG_HEAD_DIM ** -0.5),
        "rg_ba": nrm(ks[9], (DEPTH, 2, RG_HEADS, RG_HEAD_DIM), 0.02),
        "rg_wx": nrm(ks[10], (DEPTH, 2, RG_HEADS, RG_HEAD_DIM, RG_HEAD_DIM), RG_HEAD_DIM ** -0.5),
        "rg_bx": nrm(ks[11], (DEPTH, 2, RG_HEADS, RG_HEAD_DIM), 0.02),
        "rg_lambda": jnp.log(a) - jnp.log1p(-a),
        "sg_ln_g": 1.0 + nrm(ks[13], (DEPTH, D_SG), 0.02),
        "sg_ln_b": nrm(ks[14], (DEPTH, D_SG), 0.02),
        "sg_w": nrm(ks[15], (DEPTH, SG_GROUPS, SG_CHUNK, SG_CHUNK), SG_CHUNK ** -0.5),
        "sg_b": 1.0 + nrm(ks[16], (DEPTH, SG_GROUPS, SG_CHUNK), 0.02),
        "conv_c_w": nrm(ks[17], (DEPTH, CC_KERNEL, D_CC), CC_KERNEL ** -0.5),
        "conv_c_b": nrm(ks[18], (DEPTH, D_CC), 0.02),
        "cc_ln_g": 1.0 + nrm(ks[19], (DEPTH, D_CC), 0.02),
        "cc_ln_b": nrm(ks[20], (DEPTH, D_CC), 0.02),
        "w_ba": nrm(ks[21], (DEPTH, D_RG, D_MODEL), DEEPNORM_BETA * D_RG ** -0.5),
        "w_bb": nrm(ks[22], (DEPTH, D_SG, D_MODEL), DEEPNORM_BETA * D_SG ** -0.5),
        "w_bc": nrm(ks[23], (DEPTH, D_CC, D_MODEL), DEEPNORM_BETA * D_CC ** -0.5),
        "w_o": nrm(ks[24], (DEPTH, D_MODEL, D_MODEL), DEEPNORM_BETA * D_MODEL ** -0.5),
        "b_o": nrm(ks[25], (DEPTH, D_MODEL), 0.02),
        "ln1_g": 1.0 + nrm(ks[26], (DEPTH, D_MODEL), 0.02),
        "ln1_b": nrm(ks[27], (DEPTH, D_MODEL), 0.02),
        "w_ff1": nrm(ks[28], (DEPTH, D_MODEL, D_FF), DEEPNORM_BETA * D_MODEL ** -0.5),
        "b_ff1": nrm(ks[29], (DEPTH, D_FF), 0.02),
        "w_ff2": nrm(ks[30], (DEPTH, D_FF, D_MODEL), DEEPNORM_BETA * D_FF ** -0.5),
        "b_ff2": nrm(ks[31], (DEPTH, D_MODEL), 0.02),
        "ln2_g": 1.0 + nrm(ks[32], (DEPTH, D_MODEL), 0.02),
        "ln2_b": nrm(ks[33], (DEPTH, D_MODEL), 0.02),
    }


def reference(x_prompt, x_sample, ln_in_g, ln_in_b, w_in, b_in, conv_a_w, conv_a_b, rg_wa, rg_ba, rg_wx, rg_bx,
              rg_lambda, sg_ln_g, sg_ln_b, sg_w, sg_b, conv_c_w, conv_c_b, cc_ln_g, cc_ln_b, w_ba, w_bb, w_bc,
              w_o, b_o, ln1_g, ln1_b, w_ff1, b_ff1, w_ff2, b_ff2, ln2_g, ln2_b):
    params = (ln_in_g, ln_in_b, w_in, b_in, conv_a_w, conv_a_b, rg_wa, rg_ba, rg_wx, rg_bx, rg_lambda,
              sg_ln_g, sg_ln_b, sg_w, sg_b, conv_c_w, conv_c_b, cc_ln_g, cc_ln_b, w_ba, w_bb, w_bc,
              w_o, b_o, ln1_g, ln1_b, w_ff1, b_ff1, w_ff2, b_ff2, ln2_g, ln2_b)
    y_prompt = _trunk(x_prompt, *params)
    y_sample = _trunk(x_sample, *params)
    return (y_prompt, y_sample)
```

```cpp
#include <hip/hip_runtime.h>
#include <hip/hip_cooperative_groups.h>
#include <cstdio>
#include <cstdint>
namespace cg = cooperative_groups;
namespace pg8 {
#define PG8_LAS __attribute__((address_space(3)))
typedef unsigned short bf16_t;
typedef short bf16x8 __attribute__((ext_vector_type(8)));
typedef float f32x4 __attribute__((ext_vector_type(4)));
typedef unsigned u32x4 __attribute__((ext_vector_type(4)));
constexpr int BM = 256, BK = 64, HALF = 128, HTB = HALF * BK * 2  , STAGE_BYTES = 8 * HTB, NXCD = 8, WGM = 8;

__host__ __device__ __forceinline__ int lds_byte(int r, int c) { const int st = (r >> 4) * 2 + (c >> 5), rr = r & 15, cc = c & 31, ob = rr * 64 + cc * 2; return st * 1024 + (ob ^ (((ob >> 9) & 1) << 5)); }
__host__ __device__ __forceinline__ void stage_rc(int b, int& R, int& C) { const int st = b / 1024, sb = b % 1024, swz = sb ^ (((sb >> 9) & 1) << 5); R = (st >> 1) * 16 + swz / 64; C = (st & 1) * 32 + (swz % 64) / 2; }
__host__ __device__ __forceinline__ int perm32(int rho) { const int n = rho >> 4, i = rho & 15; return 8 * (i >> 2) + 4 * n + (i & 3); }

struct Unit { int pm, pn; };
struct Gemm { const bf16_t* A; const bf16_t* Bt; int M, N, K; };

struct StaticOrder {
    int nM, nN, nwg, G, c;
    __host__ __device__ void init(int M, int N, int G_, int c_) { nM = M / BM; nN = N / BM; nwg = nM * nN; G = G_; c = c_; }
    __host__ __device__ bool next(int i, Unit& u) const {
        const long L = (long)i * G + c; if (L >= nwg) return false;
        int wgid = (int)L; { const int q = nwg / NXCD, r = nwg % NXCD, xcd = wgid % NXCD, off = wgid / NXCD; wgid = (xcd < r ? xcd * (q + 1) : r * (q + 1) + (xcd - r) * q) + off; }
        const int nig = WGM * nN, gid = wgid / nig, fm = gid * WGM, gsz = (nM - fm) < WGM ? (nM - fm) : WGM;
        u.pm = fm + ((wgid % nig) % gsz); u.pn = (wgid % nig) / gsz; return true;
    }
    __device__ __forceinline__ void a_ready(const Unit&) const {}
    __device__ __forceinline__ void done(const Unit&) const {}
};
__device__ __forceinline__ unsigned cvt_pk_bf16(float lo, float hi) { unsigned r; asm volatile("v_cvt_pk_bf16_f32 %0, %1, %2" : "=v"(r) : "v"(lo), "v"(hi)); return r; }
typedef float f32x2 __attribute__((ext_vector_type(2)));
__device__ __forceinline__ float bf_lo(unsigned w) { return __uint_as_float(w << 16); }
__device__ __forceinline__ float bf_hi(unsigned w) { return __uint_as_float(w & 0xffff0000u); }
__device__ __forceinline__ float sigm(float x) { return 1.0f / (1.0f + __expf(-x)); }
__device__ __forceinline__ float gelu_tanh(float x) { const float t = x + 0.044715f * x * x * x; return x * sigm(1.5957691216057308f * t); }

struct EpiAct {
    static constexpr bool PERM = true, AFTER_DRAIN = false;
    bf16_t* O; int ldc; const float* bias; int mode;
    __device__ __forceinline__ void operator()(const f32x4 (&acc)[2][2][4][2], const Unit& u, int wr, int wc, int fr, int fq) const {
        const int row0 = u.pm * BM + wr * 64 + fr; const int colt = u.pn * BM;
        const int col0 = colt + wc * 32 + 8 * fq;
        int act;
        if (mode == 1) act = 3;
        else act = (colt < 1024) ? 0 : (colt < 3072) ? 1 : (colt < 3584) ? 0 : 2;
        f32x4 bv[2][2];
#pragma unroll
        for (int bj = 0; bj < 2; ++bj)
#pragma unroll
            for (int n = 0; n < 2; ++n) bv[bj][n] = *(const f32x4*)(bias + col0 + bj * HALF + 4 * n);
#pragma unroll
        for (int ai = 0; ai < 2; ++ai)
#pragma unroll
            for (int m = 0; m < 4; ++m) { bf16_t* rowp = O + (size_t)(row0 + ai * HALF + m * 16) * ldc + col0;
#pragma unroll
                for (int bj = 0; bj < 2; ++bj) { f32x4 v0 = acc[ai][bj][m][0] + bv[bj][0], v1 = acc[ai][bj][m][1] + bv[bj][1];
                    if (act == 1) {
#pragma unroll
                        for (int j = 0; j < 4; ++j) { v0[j] = gelu_tanh(v0[j]); v1[j] = gelu_tanh(v1[j]); } }
                    else if (act == 2) {
#pragma unroll
                        for (int j = 0; j < 4; ++j) { v0[j] = sigm(v0[j]); v1[j] = sigm(v1[j]); } }
                    else if (act == 3) {
#pragma unroll
                        for (int j = 0; j < 4; ++j) { float a = fmaxf(v0[j], 0.f), b = fmaxf(v1[j], 0.f); v0[j] = a * a; v1[j] = b * b; } }
                    u32x4 w; w.x = cvt_pk_bf16(v0[0], v0[1]); w.y = cvt_pk_bf16(v0[2], v0[3]); w.z = cvt_pk_bf16(v1[0], v1[1]); w.w = cvt_pk_bf16(v1[2], v1[3]);
                    *(u32x4*)(rowp + bj * HALF) = w; } }
    }
};

struct EpiMerge {
    static constexpr bool PERM = true, AFTER_DRAIN = false;
    const bf16_t* G; int ldg; float* MACC; bf16_t* OUT; int mode;
    __device__ __forceinline__ void operator()(const f32x4 (&acc)[2][2][4][2], const Unit& u, int wr, int wc, int fr, int fq) const {
        const int row0 = u.pm * BM + wr * 64 + fr; const int col0 = u.pn * BM + wc * 32 + 8 * fq;
#pragma unroll
        for (int ai = 0; ai < 2; ++ai)
#pragma unroll
            for (int m = 0; m < 4; ++m) { const size_t row = (size_t)(row0 + ai * HALF + m * 16);
#pragma unroll
                for (int bj = 0; bj < 2; ++bj) { const int col = col0 + bj * HALF;
                    const u32x4 g = *(const u32x4*)(G + row * ldg + col);
                    f32x4 v0 = acc[ai][bj][m][0], v1 = acc[ai][bj][m][1];
                    v0[0] *= bf_lo(g.x); v0[1] *= bf_hi(g.x); v0[2] *= bf_lo(g.y); v0[3] *= bf_hi(g.y);
                    v1[0] *= bf_lo(g.z); v1[1] *= bf_hi(g.z); v1[2] *= bf_lo(g.w); v1[3] *= bf_hi(g.w);
                    float* mp = MACC + row * 1024 + col;
                    if (mode > 0) { v0 = v0 + *(const f32x4*)(mp); v1 = v1 + *(const f32x4*)(mp + 4); }
                    if (mode < 2) { *(f32x4*)(mp) = v0; *(f32x4*)(mp + 4) = v1; }
                    else { u32x4 w; w.x = cvt_pk_bf16(v0[0], v0[1]); w.y = cvt_pk_bf16(v0[2], v0[3]); w.z = cvt_pk_bf16(v1[0], v1[1]); w.w = cvt_pk_bf16(v1[2], v1[3]);
                        *(u32x4*)(OUT + row * 1024 + col) = w; } } }
    }
};

struct EpiResid {
    static constexpr bool PERM = false, AFTER_DRAIN = false;
    float* X; const float* bias; float alpha;
    __device__ __forceinline__ void operator()(const f32x4 (&acc)[2][2][4][2], const Unit& u, int wr, int wc, int fr, int fq) const {
        const int row0 = u.pm * BM + wr * 64 + fr, col0 = u.pn * BM + wc * 32 + 4 * fq;
#pragma unroll
        for (int bj = 0; bj < 2; ++bj)
#pragma unroll
            for (int n = 0; n < 2; ++n) { const f32x4 bv = *(const f32x4*)(bias + col0 + bj * HALF + n * 16);
#pragma unroll
                for (int ai = 0; ai < 2; ++ai)
#pragma unroll
                    for (int m = 0; m < 4; ++m) { float* p = X + (size_t)(row0 + ai * HALF + m * 16) * 1024 + col0 + bj * HALF + n * 16;
                        const f32x4 xo = *(const f32x4*)p;
                        *(f32x4*)p = xo * alpha + acc[ai][bj][m][n] + bv; } }
    }
};
template <class Epi, class Sched, bool STAMP = false>
__device__ __forceinline__ void gemm_phase(PG8_LAS unsigned char* lds, const Gemm g, const Sched& S, const Epi& E, unsigned long long* stamps) {
    int tid_ = threadIdx.x; asm volatile("" : "+v"(tid_));
    const int tid = tid_, wid = __builtin_amdgcn_readfirstlane(tid >> 6), lane = tid & 63, wr = wid >> 2, wc = wid & 3, fr = lane & 15, fq = lane >> 4;
    const int K = g.K, nt = K / BK;
    int ts_lo = 0, ts_hi = 0, nts = 0; const unsigned long long rt_entry = STAMP ? (unsigned long long)wall_clock64() : 0ull;
#define PG8_STAMP() do { if (STAMP && wid == 0 && nts < 64) { const unsigned long long _c = (unsigned long long)clock64(); \
        ts_lo = (lane == nts) ? (int)(unsigned)_c : ts_lo; ts_hi = (lane == nts) ? (int)(unsigned)(_c >> 32) : ts_hi; ++nts; } } while (0)
    PG8_STAMP();
    unsigned voffA[2], voffB[2];
#pragma unroll
    for (int i = 0; i < 2; ++i) { int R, C; stage_rc(tid * 16 + i * 8192, R, C); const int Rb = Epi::PERM ? ((R & ~31) + perm32(R & 31)) : R;
        voffA[i] = (unsigned)(R * K + C) * 2u; voffB[i] = (unsigned)(Rb * K + C) * 2u; }
    const size_t kstep = (size_t)(BK * 2);
    const size_t hstep = (size_t)HALF * K * 2;
    const size_t tstep = 2 * hstep;
    const unsigned ldsw = (unsigned)wid * 1024u;
    const int aoff = lds_byte(wr * 64 + fr, fq * 8), boff = lds_byte(wc * 32 + fr, fq * 8);
#define PG8_SA(b, h) (((b) * 2 + (h)) * HTB)
#define PG8_SB(b, h) ((4 + (b) * 2 + (h)) * HTB)
#define PG8_STAGE(bufoff, gbase, voff) do { _Pragma("unroll") for (int _i = 0; _i < 2; ++_i) \
        __builtin_amdgcn_global_load_lds((const unsigned*)((const char*)(gbase) + (voff)[_i]), (PG8_LAS unsigned*)(lds + (bufoff) + ldsw + _i * 8192), 16, 0, 0); } while (0)
#define PG8_LDA(dst, b, h) do { _Pragma("unroll") for (int m = 0; m < 4; ++m) _Pragma("unroll") for (int k = 0; k < 2; ++k) dst[m][k] = *(const PG8_LAS bf16x8*)(lds + PG8_SA(b, h) + aoff + m * 2048 + k * 1024); } while (0)
#define PG8_LDB(dst, b, h) do { _Pragma("unroll") for (int n = 0; n < 2; ++n) _Pragma("unroll") for (int k = 0; k < 2; ++k) dst[n][k] = *(const PG8_LAS bf16x8*)(lds + PG8_SB(b, h) + boff + n * 2048 + k * 1024); } while (0)
#define PG8_MMA(ai, bj, At, Bt) do { __builtin_amdgcn_s_setprio(1); _Pragma("unroll") for (int m = 0; m < 4; ++m) _Pragma("unroll") for (int n = 0; n < 2; ++n) _Pragma("unroll") for (int k = 0; k < 2; ++k) \
        acc[ai][bj][m][n] = __builtin_amdgcn_mfma_f32_16x16x32_bf16(Bt[n][k], At[m][k], acc[ai][bj][m][n], 0, 0, 0); __builtin_amdgcn_s_setprio(0); } while (0)
#define PG8_WAIT_V(n) asm volatile("s_waitcnt vmcnt(" #n ")" ::: "memory")
#define PG8_WAIT_L(n) asm volatile("s_waitcnt lgkmcnt(" #n ")" ::: "memory")
#define PG8_BAR __builtin_amdgcn_s_barrier()
#define PG8_SCHED __builtin_amdgcn_sched_barrier(0)
    Unit cur, nxt; int ui = 0;
    if (!S.next(0, cur)) return;
    f32x4 acc[2][2][4][2];
#pragma unroll
    for (int a = 0; a < 2; ++a)
#pragma unroll
        for (int b = 0; b < 2; ++b)
#pragma unroll
            for (int m = 0; m < 4; ++m)
#pragma unroll
                for (int n = 0; n < 2; ++n) acc[a][b][m][n] = (f32x4){0.f, 0.f, 0.f, 0.f};
    bf16x8 At[4][2], B0[2][2], B1[2][2];
    const char* cA = (const char*)g.A + (size_t)cur.pm * tstep; const char* cB = (const char*)g.Bt + (size_t)cur.pn * tstep;
    S.a_ready(cur);
    PG8_STAGE(PG8_SB(0, 0), cB, voffB); PG8_STAGE(PG8_SA(0, 0), cA, voffA); PG8_STAGE(PG8_SB(0, 1), cB + hstep, voffB); PG8_STAGE(PG8_SA(0, 1), cA + hstep, voffA);
    if (wr == 1) PG8_BAR;
    PG8_WAIT_V(4); PG8_BAR;
    PG8_STAGE(PG8_SB(1, 0), cB + kstep, voffB); PG8_STAGE(PG8_SA(1, 0), cA + kstep, voffA); PG8_STAGE(PG8_SB(1, 1), cB + hstep + kstep, voffB);
    PG8_WAIT_V(6); PG8_BAR;
    PG8_STAMP();
    for (;;) {
        const bool has_next = S.next(ui + 1, nxt);
        const char* nA = has_next ? (const char*)g.A + (size_t)nxt.pm * tstep : cA; const char* nB = has_next ? (const char*)g.Bt + (size_t)nxt.pn * tstep : cB;
        for (int t = 0; t < nt; t += 2) {
            const bool last = (t == nt - 2);
            const char* a1 = cA + (size_t)(t + 1) * kstep;
            const char* a2 = last ? nA : cA + (size_t)(t + 2) * kstep; const char* b2 = last ? nB : cB + (size_t)(t + 2) * kstep;
            const char* a3 = a2 + kstep; const char* b3 = b2 + kstep;
            if (last && has_next) S.a_ready(nxt);
            PG8_LDB(B0, 0, 0); PG8_SCHED; PG8_LDA(At, 0, 0); PG8_STAGE(PG8_SA(1, 1), a1 + hstep, voffA);
            PG8_WAIT_L(8); PG8_BAR; PG8_WAIT_L(0); PG8_MMA(0, 0, At, B0); PG8_BAR; PG8_SCHED;
            PG8_LDB(B1, 0, 1); PG8_STAGE(PG8_SB(0, 0), b2, voffB);
            PG8_BAR; PG8_WAIT_L(0); PG8_MMA(0, 1, At, B1); PG8_BAR;
            PG8_LDA(At, 0, 1); PG8_STAGE(PG8_SA(0, 0), a2, voffA);
            PG8_BAR; PG8_WAIT_L(0); PG8_MMA(1, 0, At, B0); PG8_BAR; PG8_SCHED;
            PG8_STAGE(PG8_SB(0, 1), b2 + hstep, voffB);
            PG8_WAIT_V(6); PG8_BAR; PG8_MMA(1, 1, At, B1); PG8_BAR;
            PG8_LDB(B0, 1, 0); PG8_SCHED; PG8_LDA(At, 1, 0); PG8_STAGE(PG8_SA(0, 1), a2 + hstep, voffA);
            PG8_WAIT_L(8); PG8_BAR; PG8_WAIT_L(0); PG8_MMA(0, 0, At, B0); PG8_BAR; PG8_SCHED;
            PG8_LDB(B1, 1, 1); PG8_STAGE(PG8_SB(1, 0), b3, voffB);
            PG8_BAR; PG8_WAIT_L(0); PG8_MMA(0, 1, At, B1); PG8_BAR;
            PG8_LDA(At, 1, 1); PG8_STAGE(PG8_SA(1, 0), a3, voffA);
            PG8_BAR; PG8_WAIT_L(0); PG8_MMA(1, 0, At, B0); PG8_BAR; PG8_SCHED;
            PG8_STAGE(PG8_SB(1, 1), b3 + hstep, voffB);
            PG8_WAIT_V(6); PG8_BAR; PG8_MMA(1, 1, At, B1); PG8_BAR;
        }
        PG8_STAMP();
        if constexpr (!Epi::AFTER_DRAIN) { E(acc, cur, wr, wc, fr, fq); S.done(cur); }
        PG8_STAMP();
        if (!has_next) break;
#pragma unroll
        for (int a = 0; a < 2; ++a)
#pragma unroll
            for (int b = 0; b < 2; ++b)
#pragma unroll
                for (int m = 0; m < 4; ++m)
#pragma unroll
                    for (int n = 0; n < 2; ++n) acc[a][b][m][n] = (f32x4){0.f, 0.f, 0.f, 0.f};
        cur = nxt; cA = nA; cB = nB; ++ui;
    }
    PG8_WAIT_V(0);
    if (wr == 0) PG8_BAR;
    PG8_BAR;
    if constexpr (Epi::AFTER_DRAIN) { E.fused(acc, cur, wr, wc, fr, fq, lds, wid, lane); S.done(cur); }
    PG8_STAMP();
    if (STAMP && wid == 0) { stamps[lane] = lane < nts ? (((unsigned long long)(unsigned)ts_hi << 32) | (unsigned)ts_lo) : 0ull;
        if (lane == 62) stamps[62] = rt_entry; if (lane == 63) stamps[63] = (unsigned long long)wall_clock64(); }
#undef PG8_STAMP
#undef PG8_SA
#undef PG8_SB
#undef PG8_STAGE
#undef PG8_LDA
#undef PG8_LDB
#undef PG8_MMA
#undef PG8_WAIT_V
#undef PG8_WAIT_L
#undef PG8_BAR
#undef PG8_SCHED
}
}

using pg8::bf16_t; using pg8::bf16x8; using pg8::f32x4; using pg8::u32x4; using pg8::f32x2;
using pg8::bf_lo; using pg8::bf_hi; using pg8::sigm; using pg8::cvt_pk_bf16;
#define LAS __attribute__((address_space(3)))

constexpr int D = 1024, DIN = 7168, DFF = 4096, DEPTH = 2;
constexpr int TG = 16384, NGRP = 3;
constexpr int OFF_RG_X = 0, OFF_RG_G = 1024, OFF_SG = 2048, OFF_CC = 3072, OFF_GATE = 4096;
constexpr float LN_EPS = 1e-5f;
constexpr float ALPHA = 1.41421356237309515f;
constexpr int NT = 512;
constexpr int LDS_BYTES = 131072 + 4096;

constexpr size_t SZ_WIN = (size_t)DIN * D * 2, SZ_WBA = (size_t)D * D * 2, SZ_WBB = (size_t)D * 512 * 2, SZ_WBC = SZ_WBB, SZ_WO = SZ_WBA,
                 SZ_FF1 = (size_t)DFF * D * 2, SZ_FF2 = SZ_FF1, SZ_RG = (size_t)2 * 8 * 128 * 128 * 2, SZ_SGW = (size_t)4 * 128 * 128 * 2;
constexpr size_t LW_WIN = 0, LW_WBA = LW_WIN + SZ_WIN, LW_WBB = LW_WBA + SZ_WBA, LW_WBC = LW_WBB + SZ_WBB, LW_WO = LW_WBC + SZ_WBC,
                 LW_FF1 = LW_WO + SZ_WO, LW_FF2 = LW_FF1 + SZ_FF1, LW_RGA = LW_FF2 + SZ_FF2, LW_RGX = LW_RGA + SZ_RG, LW_SGW = LW_RGX + SZ_RG,
                 LW_END = LW_SGW + SZ_SGW;
constexpr size_t WS_W = 0, WS_XB = WS_W + DEPTH * LW_END, WS_PROJ = WS_XB + (size_t)TG * D * 2, WS_BA = WS_PROJ + (size_t)TG * DIN * 2,
                 WS_BB = WS_BA + (size_t)TG * D * 2, WS_BC = WS_BB + (size_t)TG * 512 * 2, WS_MACC = WS_BC + (size_t)TG * 512 * 2,
                 WS_AGG = WS_MACC + (size_t)TG * D * 4, WS_END = WS_AGG + (size_t)128 * 2 * 2 * 1024 * 4;

struct Args { const float* in[34]; float* out; unsigned char* ws; };

struct Ctx {
    float* out; unsigned char* ws;
    LAS unsigned char* lds;
    int tid, lane, wave, G, bid;
};

__device__ __forceinline__ int opaque(int x) { asm volatile("" : "+v"(x)); return x; }
__device__ __forceinline__ unsigned f2bf(float f) { unsigned u = __float_as_uint(f); return (u + 0x7fffu + ((u >> 16) & 1u)) >> 16; }
__device__ __forceinline__ float bf2f(bf16_t b) { return __uint_as_float(((unsigned)b) << 16); }
__device__ __forceinline__ float wave_sum(float v) {
#pragma unroll
    for (int o = 1; o < 64; o <<= 1) v += __shfl_xor(v, o);
    return v;
}

__device__ __forceinline__ void transpose_item(const float* W, int K, int N, bf16_t* WT, LAS float* scr, int item, int lane) {
    const int nblk = N / 32, kb = item / nblk, nb = item % nblk, k0 = 64 * kb, n0 = 32 * nb;
#pragma unroll 8
    for (int i = 0; i < 32; ++i) { const int kk = 2 * i + (lane >> 5); scr[kk * 33 + (lane & 31)] = W[(size_t)(k0 + kk) * N + n0 + (lane & 31)]; }
    asm volatile("s_waitcnt lgkmcnt(0)" ::: "memory");
    const int c = lane & 7;
#pragma unroll
    for (int j = 0; j < 4; ++j) { const int n = (lane >> 3) + 8 * j; const LAS float* s = scr + (8 * c) * 33 + n;
        u32x4 o; o.x = f2bf(s[0 * 33]) | (f2bf(s[1 * 33]) << 16); o.y = f2bf(s[2 * 33]) | (f2bf(s[3 * 33]) << 16);
        o.z = f2bf(s[4 * 33]) | (f2bf(s[5 * 33]) << 16); o.w = f2bf(s[6 * 33]) | (f2bf(s[7 * 33]) << 16);
        *(u32x4*)(WT + (size_t)(n0 + n) * K + k0 + 8 * c) = o; }
    asm volatile("s_waitcnt lgkmcnt(0)" ::: "memory");
}
__device__ __forceinline__ void transpose_job(const Ctx& C, const float* W, int K, int N, int nmat, bf16_t* WT) {
    const int tid = opaque(C.tid), lane = tid & 63, wave = __builtin_amdgcn_readfirstlane(tid >> 6);
    LAS float* scr = (LAS float*)(C.lds + wave * 8704);
    const int per = (K / 64) * (N / 32), total = per * nmat;
    const int gw = C.bid * 8 + wave, NGW = C.G * 8;
    for (int it = gw; it < total; it += NGW) { const int mat = it / per, r = it % per;
        transpose_item(W + (size_t)mat * K * N, K, N, WT + (size_t)mat * K * N, scr, r, lane); }
}
__device__ __forceinline__ void convert_job(const Ctx& C, const float* W, size_t n, bf16_t* O) {
    const size_t gt = (size_t)C.bid * NT + opaque(C.tid), NGT = (size_t)C.G * NT;
    for (size_t i = gt * 4; i < n; i += NGT * 4) { const f32x4 v = *(const f32x4*)(W + i);
        unsigned long long o = (unsigned long long)(f2bf(v[0]) | (f2bf(v[1]) << 16)) | ((unsigned long long)(f2bf(v[2]) | (f2bf(v[3]) << 16)) << 32);
        *(unsigned long long*)(O + i) = o; }
}
__device__ __forceinline__ void prologue_weights(const Ctx& C, const Args& AR) {
    for (int l = 0; l < DEPTH; ++l) {
        unsigned char* wl = C.ws + WS_W + (size_t)l * LW_END;
        transpose_job(C, AR.in[4] + (size_t)l * D * DIN, D, DIN, 1, (bf16_t*)(wl + LW_WIN));
        transpose_job(C, AR.in[21] + (size_t)l * D * D, D, D, 1, (bf16_t*)(wl + LW_WBA));
        transpose_job(C, AR.in[22] + (size_t)l * 512 * D, 512, D, 1, (bf16_t*)(wl + LW_WBB));
        transpose_job(C, AR.in[23] + (size_t)l * 512 * D, 512, D, 1, (bf16_t*)(wl + LW_WBC));
        transpose_job(C, AR.in[24] + (size_t)l * D * D, D, D, 1, (bf16_t*)(wl + LW_WO));
        transpose_job(C, AR.in[28] + (size_t)l * D * DFF, D, DFF, 1, (bf16_t*)(wl + LW_FF1));
        transpose_job(C, AR.in[30] + (size_t)l * DFF * D, DFF, D, 1, (bf16_t*)(wl + LW_FF2));
        transpose_job(C, AR.in[8] + (size_t)l * 16 * 16384, 128, 128, 16, (bf16_t*)(wl + LW_RGA));
        transpose_job(C, AR.in[10] + (size_t)l * 16 * 16384, 128, 128, 16, (bf16_t*)(wl + LW_RGX));
        convert_job(C, AR.in[15] + (size_t)l * 4 * 16384, (size_t)4 * 16384, (bf16_t*)(wl + LW_SGW));
    }
}

__device__ __forceinline__ void ln_rows(const Ctx& C, const float* src, float* dstf, bf16_t* dstb, const float* g, const float* b, int nrows) {
    const int tid = opaque(C.tid), lane = tid & 63, wave = __builtin_amdgcn_readfirstlane(tid >> 6);
    const int gw = C.bid * 8 + wave, NGW = C.G * 8;
    f32x4 gv[4], bv[4];
#pragma unroll
    for (int j = 0; j < 4; ++j) { gv[j] = *(const f32x4*)(g + 4 * lane + 256 * j); bv[j] = *(const f32x4*)(b + 4 * lane + 256 * j); }
    for (int r = gw; r < nrows; r += NGW) {
        const float* xr = src + (size_t)r * D + 4 * lane;
        f32x4 v[4]; float s = 0.f;
#pragma unroll
        for (int j = 0; j < 4; ++j) { v[j] = *(const f32x4*)(xr + 256 * j); s += (v[j][0] + v[j][1]) + (v[j][2] + v[j][3]); }
        const float mean = wave_sum(s) * (1.f / D); float s2 = 0.f;
#pragma unroll
        for (int j = 0; j < 4; ++j) { v[j] = v[j] - mean; s2 += (v[j][0] * v[j][0] + v[j][1] * v[j][1]) + (v[j][2] * v[j][2] + v[j][3] * v[j][3]); }
        const float rstd = 1.f / sqrtf(wave_sum(s2) * (1.f / D) + LN_EPS);
#pragma unroll
        for (int j = 0; j < 4; ++j) { const f32x4 y = v[j] * rstd * gv[j] + bv[j];
            *(f32x4*)(dstf + (size_t)r * D + 4 * lane + 256 * j) = y;
            if (dstb) { unsigned long long o = (unsigned long long)cvt_pk_bf16(y[0], y[1]) | ((unsigned long long)cvt_pk_bf16(y[2], y[3]) << 32);
                *(unsigned long long*)(dstb + (size_t)r * D + 4 * lane + 256 * j) = o; } }
    }
}

__device__ __forceinline__ float softplusf_(float x) { return fmaxf(x, 0.f) + log1pf(__expf(-fabsf(x))); }
__device__ __forceinline__ float expm1_neg(float x) {
    const float p = x * (1.f + x * (0.5f + x * (0.16666667f + x * (0.041666668f + x * (0.0083333338f + x * (0.0013888889f + x * 0.00019841270f))))));
    const float e = __expf(x) - 1.0f;
    return (x > -0.25f) ? p : e;
}

template <int PASS>
__device__ __forceinline__ void rg_unit(const Ctx& C, const Args& AR, int layer, int grp, int chunk, int head) {
    const int tid = opaque(C.tid), lane = tid & 63, wave = __builtin_amdgcn_readfirstlane(tid >> 6), fr = lane & 15, fq = lane >> 4;
    const int L = (grp == 0) ? 16384 : 2048;
    const int t0 = chunk * 128, s0 = (t0 / L) * L, s1 = s0 + L;
    const bf16_t* P = (const bf16_t*)(C.ws + WS_PROJ);
    LAS bf16_t* xa = (LAS bf16_t*)C.lds;
    const unsigned char* wl = C.ws + WS_W + (size_t)layer * LW_END;
    {
        const float* cw = AR.in[6] + (size_t)layer * 4 * 1024 + head * 128;
        const float* cb = AR.in[7] + (size_t)layer * 1024 + head * 128;
#pragma unroll 1
        for (int item = tid; item < 2048; item += NT) {
            const int t = item >> 4, c8 = (item & 15) * 8;
            f32x4 o0 = *(const f32x4*)(cb + c8), o1 = *(const f32x4*)(cb + c8 + 4);
#pragma unroll
            for (int k = 0; k < 4; ++k) { const int tt = t0 + t - 2 + k;
                if (tt >= s0 && tt < s1) {
                    const u32x4 xv = *(const u32x4*)(P + (size_t)tt * DIN + OFF_RG_X + head * 128 + c8);
                    const f32x4 w0 = *(const f32x4*)(cw + k * 1024 + c8), w1 = *(const f32x4*)(cw + k * 1024 + c8 + 4);
                    o0[0] += bf_lo(xv.x) * w0[0]; o0[1] += bf_hi(xv.x) * w0[1]; o0[2] += bf_lo(xv.y) * w0[2]; o0[3] += bf_hi(xv.y) * w0[3];
                    o1[0] += bf_lo(xv.z) * w1[0]; o1[1] += bf_hi(xv.z) * w1[1]; o1[2] += bf_lo(xv.w) * w1[2]; o1[3] += bf_hi(xv.w) * w1[3]; } }
            u32x4 w; w.x = cvt_pk_bf16(o0[0], o0[1]); w.y = cvt_pk_bf16(o0[2], o0[3]); w.z = cvt_pk_bf16(o1[0], o1[1]); w.w = cvt_pk_bf16(o1[2], o1[3]);
            *(LAS u32x4*)(xa + t * 136 + c8) = w; }
    }
    __syncthreads();
    const int chl = wave * 16 + fr;
    const int ch = head * 128 + chl;
    float* agg = (float*)(C.ws + WS_AGG);
    f32x4 hsum[8];
#pragma unroll
    for (int d = 0; d < 2; ++d) {
        const bf16_t* Wa = (const bf16_t*)(wl + LW_RGA) + (size_t)(d * 8 + head) * 16384;
        const bf16_t* Wx = (const bf16_t*)(wl + LW_RGX) + (size_t)(d * 8 + head) * 16384;
        bf16x8 Ba[4], Bx[4];
#pragma unroll
        for (int k = 0; k < 4; ++k) { Ba[k] = *(const bf16x8*)(Wa + (size_t)chl * 128 + k * 32 + fq * 8); Bx[k] = *(const bf16x8*)(Wx + (size_t)chl * 128 + k * 32 + fq * 8); }
        const int pidx = (layer * 2 + d) * 1024 + ch;
        const float ba = AR.in[9][pidx], bx = AR.in[11][pidx], lam = AR.in[12][pidx];
        const float logac = -8.0f * softplusf_(-lam);
        float H = 0.f, Pp = 1.f;
        if (PASS == 2) {
            const int cfirst = s0 / 128, clast = s1 / 128 - 1;
            if (d == 0) {
#pragma unroll 4
                for (int c = cfirst; c < chunk; ++c) { const float pj = agg[(size_t)(c * 2 + 0) * 2048 + ch], ej = agg[(size_t)(c * 2 + 0) * 2048 + 1024 + ch]; H = pj * H + ej; } }
            else {
#pragma unroll 4
                for (int c = clast; c > chunk; --c) { const float pj = agg[(size_t)(c * 2 + 1) * 2048 + ch], ej = agg[(size_t)(c * 2 + 1) * 2048 + 1024 + ch]; H = pj * H + ej; } }
        }
#pragma unroll
        for (int mm = 0; mm < 8; ++mm) {
            const int m = (d == 0) ? mm : 7 - mm;
            f32x4 ar = (f32x4){0.f, 0.f, 0.f, 0.f}, ai = (f32x4){0.f, 0.f, 0.f, 0.f};
#pragma unroll
            for (int k = 0; k < 4; ++k) { const bf16x8 A = *(const LAS bf16x8*)(xa + (m * 16 + fr) * 136 + k * 32 + fq * 8);
                ar = __builtin_amdgcn_mfma_f32_16x16x32_bf16(A, Ba[k], ar, 0, 0, 0);
                ai = __builtin_amdgcn_mfma_f32_16x16x32_bf16(A, Bx[k], ai, 0, 0, 0); }
            float a[4], u[4];
#pragma unroll
            for (int j = 0; j < 4; ++j) {
                const float r = sigm(ar[j] + ba), ig = sigm(ai[j] + bx);
                const float la = r * logac; a[j] = __expf(la); const float om = -expm1_neg(2.0f * la);
                const float xv = bf2f(xa[(m * 16 + fq * 4 + j) * 136 + chl]);
                u[j] = sqrtf(fmaxf(om, 0.f)) * (ig * xv); }
            const float a0 = a[0], a1 = a[1], a2 = a[2], a3 = a[3], u0 = u[0], u1 = u[1], u2 = u[2], u3 = u[3];
            const float Aloc = (a0 * a1) * (a2 * a3);
            const float Bloc = (d == 0) ? (((u0 * a1 + u1) * a2 + u2) * a3 + u3) : (((u3 * a2 + u2) * a1 + u1) * a0 + u0);
            const float A0 = __shfl(Aloc, fr), B0 = __shfl(Bloc, fr), A1 = __shfl(Aloc, fr + 16), B1 = __shfl(Bloc, fr + 16);
            const float A2 = __shfl(Aloc, fr + 32), B2 = __shfl(Bloc, fr + 32), A3 = __shfl(Aloc, fr + 48), B3 = __shfl(Bloc, fr + 48);
            float hin, S4;
            if (d == 0) { const float S1 = A0 * H + B0, S2 = A1 * S1 + B1, S3 = A2 * S2 + B2; S4 = A3 * S3 + B3;
                hin = (fq == 0) ? H : (fq == 1) ? S1 : (fq == 2) ? S2 : S3; }
            else { const float S1 = A3 * H + B3, S2 = A2 * S1 + B2, S3 = A1 * S2 + B1; S4 = A0 * S3 + B0;
                hin = (fq == 3) ? H : (fq == 2) ? S1 : (fq == 1) ? S2 : S3; }
            if (PASS == 2) {
                if (d == 0) { const float h0 = a0 * hin + u0, h1 = a1 * h0 + u1, h2 = a2 * h1 + u2, h3 = a3 * h2 + u3; hsum[m] = (f32x4){h0, h1, h2, h3}; }
                else { const float h3 = a3 * hin + u3, h2 = a2 * h3 + u2, h1 = a1 * h2 + u1, h0 = a0 * h1 + u0; hsum[m] = hsum[m] + (f32x4){h0, h1, h2, h3}; }
            } else { Pp *= (A0 * A1) * (A2 * A3); }
            H = S4;
            __builtin_amdgcn_sched_barrier(0);
        }
        if (PASS == 1) { if (fq == 0) { agg[(size_t)(chunk * 2 + d) * 2048 + ch] = Pp; agg[(size_t)(chunk * 2 + d) * 2048 + 1024 + ch] = H; } }
    }
    if (PASS == 2) {
        bf16_t* BA = (bf16_t*)(C.ws + WS_BA);
#pragma unroll
        for (int m = 0; m < 8; ++m)
#pragma unroll
            for (int j = 0; j < 4; ++j) { const unsigned t = (unsigned)(t0 + m * 16 + fq * 4 + j);
                const float gg = bf2f(P[t * (unsigned)DIN + (unsigned)(OFF_RG_G + ch)]);
                BA[t * 1024u + (unsigned)ch] = (bf16_t)f2bf(hsum[m][j] * gg);
                if (j == 3) __builtin_amdgcn_sched_barrier(0); }
    }
    __syncthreads();
}
__device__ __forceinline__ void sg_unit(const Ctx& C, const Args& AR, int layer, int chunk, int g) {
    const int tid = opaque(C.tid), lane = tid & 63, wave = __builtin_amdgcn_readfirstlane(tid >> 6), fr = lane & 15, fq = lane >> 4;
    const int t0 = chunk * 128;
    const bf16_t* P = (const bf16_t*)(C.ws + WS_PROJ);
    LAS bf16_t* Vt = (LAS bf16_t*)C.lds;
    const unsigned char* wl = C.ws + WS_W + (size_t)layer * LW_END;
    {
        const int q = tid >> 2, sub = tid & 3;
        const bf16_t* vrow = P + (size_t)(t0 + q) * DIN + OFF_SG + 512;
        float s = 0.f, ss = 0.f;
#pragma unroll
        for (int i = 0; i < 16; ++i) { const u32x4 w = *(const u32x4*)(vrow + sub * 128 + i * 8);
            const float v0 = bf_lo(w.x), v1 = bf_hi(w.x), v2 = bf_lo(w.y), v3 = bf_hi(w.y), v4 = bf_lo(w.z), v5 = bf_hi(w.z), v6 = bf_lo(w.w), v7 = bf_hi(w.w);
            s += ((v0 + v1) + (v2 + v3)) + ((v4 + v5) + (v6 + v7));
            ss += ((v0 * v0 + v1 * v1) + (v2 * v2 + v3 * v3)) + ((v4 * v4 + v5 * v5) + (v6 * v6 + v7 * v7)); }
        s += __shfl_xor(s, 1); s += __shfl_xor(s, 2); ss += __shfl_xor(ss, 1); ss += __shfl_xor(ss, 2);
        const float mean = s * (1.f / 512.f); const float var = fmaxf(ss * (1.f / 512.f) - mean * mean, 0.f);
        const float rstd = 1.f / sqrtf(var + LN_EPS);
        const float* lg = AR.in[13] + (size_t)layer * 512 + g * 128; const float* lb = AR.in[14] + (size_t)layer * 512 + g * 128;
#pragma unroll
        for (int i = 0; i < 4; ++i) { const int d0 = sub * 32 + i * 8;
            const u32x4 w = *(const u32x4*)(vrow + g * 128 + d0);
            const f32x4 g0 = *(const f32x4*)(lg + d0), g1 = *(const f32x4*)(lg + d0 + 4), b0 = *(const f32x4*)(lb + d0), b1 = *(const f32x4*)(lb + d0 + 4);
            float v[8] = {bf_lo(w.x), bf_hi(w.x), bf_lo(w.y), bf_hi(w.y), bf_lo(w.z), bf_hi(w.z), bf_lo(w.w), bf_hi(w.w)};
#pragma unroll
            for (int e = 0; e < 8; ++e) { const float gg = (e < 4) ? g0[e & 3] : g1[e & 3], bb = (e < 4) ? b0[e & 3] : b1[e & 3];
                Vt[(d0 + e) * 136 + q] = (bf16_t)f2bf((v[e] - mean) * rstd * gg + bb); } }
    }
    __syncthreads();
    {
        const bf16_t* W = (const bf16_t*)(wl + LW_SGW) + (size_t)g * 16384;
        bf16x8 A[4];
#pragma unroll
        for (int k = 0; k < 4; ++k) A[k] = *(const bf16x8*)(W + (size_t)(wave * 16 + fr) * 128 + k * 32 + fq * 8);
        const float* sgb = AR.in[16] + (size_t)(layer * 4 + g) * 128;
        bf16_t* BB = (bf16_t*)(C.ws + WS_BB);
#pragma unroll
        for (int n = 0; n < 8; ++n) { f32x4 acc = (f32x4){0.f, 0.f, 0.f, 0.f};
#pragma unroll
            for (int k = 0; k < 4; ++k) { const bf16x8 B = *(const LAS bf16x8*)(Vt + (n * 16 + fr) * 136 + k * 32 + fq * 8);
                acc = __builtin_amdgcn_mfma_f32_16x16x32_bf16(A[k], B, acc, 0, 0, 0); }
#pragma unroll
            for (int j = 0; j < 4; ++j) { const int p = wave * 16 + fq * 4 + j; const size_t t = (size_t)(t0 + p);
                const float sp = acc[j] + sgb[p];
                const float uu = bf2f(P[t * DIN + OFF_SG + g * 128 + n * 16 + fr]);
                BB[t * 512 + g * 128 + n * 16 + fr] = (bf16_t)f2bf(uu * sp); } }
    }
    __syncthreads();
}

__device__ __forceinline__ void cc_unit(const Ctx& C, const Args& AR, int layer, int grp, int tile) {
    const int tid = opaque(C.tid), lane = tid & 63, wave = __builtin_amdgcn_readfirstlane(tid >> 6);
    const int L = (grp == 0) ? 16384 : 2048;
    const int t0 = tile * 64, s0 = (t0 / L) * L, s1 = s0 + L;
    const bf16_t* P = (const bf16_t*)(C.ws + WS_PROJ);
    LAS bf16_t* cbuf = (LAS bf16_t*)C.lds;
    LAS float* part = (LAS float*)(C.lds + 94 * 1024);
#pragma unroll 1
    for (int item = tid; item < 94 * 64; item += NT) {
        const int r = item >> 6, c8 = (item & 63) * 8, tt = t0 - 15 + r;
        u32x4 w = (u32x4){0u, 0u, 0u, 0u};
        if (tt >= s0 && tt < s1) {
            const u32x4 a = *(const u32x4*)(P + (size_t)tt * DIN + OFF_CC + c8), sg = *(const u32x4*)(P + (size_t)tt * DIN + OFF_CC + 512 + c8);
            w.x = cvt_pk_bf16(bf_lo(a.x) * bf_lo(sg.x), bf_hi(a.x) * bf_hi(sg.x)); w.y = cvt_pk_bf16(bf_lo(a.y) * bf_lo(sg.y), bf_hi(a.y) * bf_hi(sg.y));
            w.z = cvt_pk_bf16(bf_lo(a.z) * bf_lo(sg.z), bf_hi(a.z) * bf_hi(sg.z)); w.w = cvt_pk_bf16(bf_lo(a.w) * bf_lo(sg.w), bf_hi(a.w) * bf_hi(sg.w)); }
        *(LAS u32x4*)(cbuf + r * 512 + c8) = w; }
    __syncthreads();
    const int cp = tid & 255, half = tid >> 8, ch0 = 2 * cp;
    const float* cw = AR.in[17] + (size_t)layer * 31 * 512 + ch0;
    const f32x2 cb = *(const f32x2*)(AR.in[18] + (size_t)layer * 512 + ch0);
    f32x2 y[32];
#pragma unroll
    for (int tt = 0; tt < 32; ++tt) y[tt] = cb;
#pragma unroll 1
    for (int k = 0; k < 31; ++k) {
        const f32x2 w = *(const f32x2*)(cw + k * 512);
        const LAS unsigned* base = (const LAS unsigned*)(cbuf + (half * 32 + k) * 512 + ch0);
#pragma unroll
        for (int tt = 0; tt < 32; ++tt) { const unsigned c = base[tt * 256]; y[tt][0] += bf_lo(c) * w[0]; y[tt][1] += bf_hi(c) * w[1]; }
    }
#pragma unroll
    for (int tt = 0; tt < 32; ++tt) {
        float s = y[tt][0] + y[tt][1], ss = y[tt][0] * y[tt][0] + y[tt][1] * y[tt][1];
        s = wave_sum(s); ss = wave_sum(ss);
        if (lane == 0) { part[((half * 32 + tt) * 4 + (wave & 3)) * 2] = s; part[((half * 32 + tt) * 4 + (wave & 3)) * 2 + 1] = ss; }
    }
    __syncthreads();
    const f32x2 lg = *(const f32x2*)(AR.in[19] + (size_t)layer * 512 + ch0), lb = *(const f32x2*)(AR.in[20] + (size_t)layer * 512 + ch0);
    bf16_t* BC = (bf16_t*)(C.ws + WS_BC);
#pragma unroll
    for (int tt = 0; tt < 32; ++tt) {
        const LAS float* pp = part + (half * 32 + tt) * 8;
        const float s = (pp[0] + pp[2]) + (pp[4] + pp[6]), ss = (pp[1] + pp[3]) + (pp[5] + pp[7]);
        const float mean = s * (1.f / 512.f); const float var = fmaxf(ss * (1.f / 512.f) - mean * mean, 0.f);
        const float rstd = 1.f / sqrtf(var + LN_EPS);
        const float z0 = (y[tt][0] - mean) * rstd * lg[0] + lb[0], z1 = (y[tt][1] - mean) * rstd * lg[1] + lb[1];
        *(unsigned*)(BC + (size_t)(t0 + half * 32 + tt) * 512 + ch0) = cvt_pk_bf16(z0 * sigm(z0), z1 * sigm(z1));
    }
    __syncthreads();
}
template <class Epi>
__device__ __forceinline__ void run_gemm(const Ctx& C, const bf16_t* A, const bf16_t* Bt, int M, int N, int K, const Epi& E) {
    pg8::Gemm g{A, Bt, M, N, K}; pg8::StaticOrder S; S.init(M, N, C.G, C.bid);
    pg8::gemm_phase<Epi, pg8::StaticOrder, false>(C.lds, g, S, E, nullptr);
}

__global__ void __launch_bounds__(NT, 2) fwd_kernel(Args args) {
    extern __shared__ __attribute__((aligned(16))) unsigned char shm[];
    cg::grid_group grid = cg::this_grid();
    Ctx C; C.out = args.out; C.ws = args.ws; C.lds = (LAS unsigned char*)shm;
    C.tid = threadIdx.x; C.lane = C.tid & 63; C.wave = __builtin_amdgcn_readfirstlane(C.tid >> 6); C.G = gridDim.x; C.bid = blockIdx.x;

    bf16_t* XB = (bf16_t*)(C.ws + WS_XB);
    bf16_t* PROJ = (bf16_t*)(C.ws + WS_PROJ);
    bf16_t* HID = PROJ;
    bf16_t* BA = (bf16_t*)(C.ws + WS_BA); bf16_t* BB = (bf16_t*)(C.ws + WS_BB); bf16_t* BC = (bf16_t*)(C.ws + WS_BC);
    float* MACC = (float*)(C.ws + WS_MACC);
    bf16_t* MERGED = XB;

    prologue_weights(C, args);
    ln_rows(C, args.in[0], C.out, XB, args.in[2], args.in[3], TG);
    grid.sync();

#pragma unroll 1
    for (int grp = 0; grp < NGRP; ++grp) {
        float* X = C.out + (size_t)grp * TG * D;
#pragma unroll 1
        for (int layer = 0; layer < DEPTH; ++layer) {
            const unsigned char* wl = C.ws + WS_W + (size_t)layer * LW_END;
            { pg8::EpiAct E{PROJ, DIN, args.in[5] + (size_t)layer * DIN, 0};
              run_gemm(C, XB, (const bf16_t*)(wl + LW_WIN), TG, DIN, D, E); }
            grid.sync();
#pragma unroll 1
            for (int u = C.bid; u < 1792; u += C.G) {
                if (u < 1024) rg_unit<1>(C, args, layer, grp, u >> 3, u & 7);
                else if (u < 1536) sg_unit(C, args, layer, (u - 1024) >> 2, (u - 1024) & 3);
                else cc_unit(C, args, layer, grp, u - 1536);
            }
            grid.sync();
#pragma unroll 1
            for (int u = C.bid; u < 1024; u += C.G) rg_unit<2>(C, args, layer, grp, u >> 3, u & 7);
            grid.sync();
            { pg8::EpiMerge E0{PROJ + OFF_GATE, DIN, MACC, MERGED, 0};
              run_gemm(C, BA, (const bf16_t*)(wl + LW_WBA), TG, D, D, E0);
              pg8::EpiMerge E1{PROJ + OFF_GATE + 1024, DIN, MACC, MERGED, 1};
              run_gemm(C, BB, (const bf16_t*)(wl + LW_WBB), TG, D, 512, E1);
              pg8::EpiMerge E2{PROJ + OFF_GATE + 2048, DIN, MACC, MERGED, 2};
              run_gemm(C, BC, (const bf16_t*)(wl + LW_WBC), TG, D, 512, E2); }
            grid.sync();
            { pg8::EpiResid E{X, args.in[25] + (size_t)layer * D, ALPHA};
              run_gemm(C, MERGED, (const bf16_t*)(wl + LW_WO), TG, D, D, E); }
            grid.sync();
            ln_rows(C, X, X, XB, args.in[26] + (size_t)layer * D, args.in[27] + (size_t)layer * D, TG);
            grid.sync();
            { pg8::EpiAct E{HID, DFF, args.in[29] + (size_t)layer * DFF, 1};
              run_gemm(C, XB, (const bf16_t*)(wl + LW_FF1), TG, DFF, D, E); }
            grid.sync();
            { pg8::EpiResid E{X, args.in[31] + (size_t)layer * D, ALPHA};
              run_gemm(C, HID, (const bf16_t*)(wl + LW_FF2), TG, D, DFF, E); }
            grid.sync();
            const bool last = (layer == DEPTH - 1);
            ln_rows(C, X, X, last ? (bf16_t*)nullptr : XB, args.in[32] + (size_t)layer * D, args.in[33] + (size_t)layer * D, TG);
            if (last && grp + 1 < NGRP)
                ln_rows(C, args.in[1] + (size_t)grp * TG * D, C.out + (size_t)(grp + 1) * TG * D, XB, args.in[2], args.in[3], TG);
            grid.sync();
        }
    }
}

extern "C" void kernel_launch(void* const* d_in, const int* in_sizes, int n_in, void* d_out, int out_size, void* d_ws, size_t ws_size, hipStream_t stream) {
    static int grid = 0;
    if (grid == 0) {
        if (n_in != 34 || ws_size < WS_END) { fprintf(stderr, "kernel_launch: unexpected n_in %d / ws_size %zu (need %zu)\n", n_in, ws_size, (size_t)WS_END); grid = -1; return; }
        int dev = 0, cus = 0, per_cu = 0;
        hipGetDevice(&dev);
        hipDeviceGetAttribute(&cus, hipDeviceAttributeMultiprocessorCount, dev);
        hipFuncSetAttribute((const void*)fwd_kernel, hipFuncAttributeMaxDynamicSharedMemorySize, LDS_BYTES);
        hipOccupancyMaxActiveBlocksPerMultiprocessor(&per_cu, (const void*)fwd_kernel, NT, LDS_BYTES);
        if (per_cu < 1) per_cu = 1;
        grid = cus * per_cu;
        (void)hipGetLastError();
    }
    if (grid < 0) return;
    Args a{};
    for (int i = 0; i < 34; ++i) a.in[i] = (const float*)d_in[i];
    a.out = (float*)d_out; a.ws = (unsigned char*)d_ws;
    void* kargs[] = {&a};
    hipError_t e = hipLaunchCooperativeKernel((const void*)fwd_kernel, dim3(grid), dim3(NT), kargs, LDS_BYTES, stream);
    if (e != hipSuccess) fprintf(stderr, "cooperative launch failed: %s (grid %d)\n", hipGetErrorString(e), grid);
}

#ifdef TESTK
#define MKCTX extern __shared__ __attribute__((aligned(16))) unsigned char shm[]; Ctx C; C.out = args.out; C.ws = args.ws; C.lds = (LAS unsigned char*)shm; \
    C.tid = threadIdx.x; C.lane = C.tid & 63; C.wave = __builtin_amdgcn_readfirstlane(C.tid >> 6); C.G = gridDim.x; C.bid = blockIdx.x;
__global__ void __launch_bounds__(NT, 2) t_prol(Args args) { MKCTX prologue_weights(C, args); ln_rows(C, args.in[0], C.out, (bf16_t*)(C.ws + WS_XB), args.in[2], args.in[3], TG); }
__global__ void __launch_bounds__(NT, 2) t_rg1(Args args, int layer, int grp) { MKCTX for (int u = C.bid; u < 1024; u += C.G) rg_unit<1>(C, args, layer, grp, u >> 3, u & 7); }
__global__ void __launch_bounds__(NT, 2) t_rg2(Args args, int layer, int grp) { MKCTX for (int u = C.bid; u < 1024; u += C.G) rg_unit<2>(C, args, layer, grp, u >> 3, u & 7); }
__global__ void __launch_bounds__(NT, 2) t_sg(Args args, int layer, int grp) { MKCTX for (int u = C.bid; u < 512; u += C.G) sg_unit(C, args, layer, u >> 2, u & 3); }
__global__ void __launch_bounds__(NT, 2) t_cc(Args args, int layer, int grp) { MKCTX for (int u = C.bid; u < 256; u += C.G) cc_unit(C, args, layer, grp, u); }
__global__ void __launch_bounds__(NT, 2) t_g1(Args args, int layer) { MKCTX pg8::EpiAct E{(bf16_t*)(C.ws + WS_PROJ), DIN, args.in[5] + (size_t)layer * DIN, 0}; run_gemm(C, (bf16_t*)(C.ws + WS_XB), (const bf16_t*)(C.ws), TG, DIN, D, E); }
__global__ void __launch_bounds__(NT, 2) t_g3(Args args, int layer, int mode) { MKCTX pg8::EpiMerge E{(bf16_t*)(C.ws + WS_PROJ), DIN, (float*)(C.ws + WS_MACC), (bf16_t*)(C.ws + WS_XB), mode}; run_gemm(C, (bf16_t*)(C.ws + WS_BA), (const bf16_t*)(C.ws), TG, D, D, E); }
__global__ void __launch_bounds__(NT, 2) t_g4(Args args, int layer) { MKCTX pg8::EpiResid E{C.out, args.in[25] + (size_t)layer * D, ALPHA}; run_gemm(C, (bf16_t*)(C.ws + WS_XB), (const bf16_t*)(C.ws), TG, D, D, E); }
#endif
```

```cpp
#include <hip/hip_runtime.h>
#include <hip/hip_cooperative_groups.h>
#include <cstdio>
#include <cstdint>
namespace cg = cooperative_groups;
namespace pg8 {
#define PG8_LAS __attribute__((address_space(3)))
typedef unsigned short bf16_t;
typedef short bf16x8 __attribute__((ext_vector_type(8)));
typedef float f32x4 __attribute__((ext_vector_type(4)));
typedef unsigned u32x4 __attribute__((ext_vector_type(4)));
constexpr int BM = 256, BK = 64, HALF = 128, HTB = HALF * BK * 2  , STAGE_BYTES = 8 * HTB, NXCD = 8, WGM = 8;

__host__ __device__ __forceinline__ int lds_byte(int r, int c) { const int st = (r >> 4) * 2 + (c >> 5), rr = r & 15, cc = c & 31, ob = rr * 64 + cc * 2; return st * 1024 + (ob ^ (((ob >> 9) & 1) << 5)); }
__host__ __device__ __forceinline__ void stage_rc(int b, int& R, int& C) { const int st = b / 1024, sb = b % 1024, swz = sb ^ (((sb >> 9) & 1) << 5); R = (st >> 1) * 16 + swz / 64; C = (st & 1) * 32 + (swz % 64) / 2; }
__host__ __device__ __forceinline__ int perm32(int rho) { const int n = rho >> 4, i = rho & 15; return 8 * (i >> 2) + 4 * n + (i & 3); }

struct Unit { int pm, pn; };
struct Gemm { const bf16_t* A; const bf16_t* Bt; int M, N, K; };

struct StaticOrder {
    int nM, nN, nwg, G, c;
    __host__ __device__ void init(int M, int N, int G_, int c_) { nM = M / BM; nN = N / BM; nwg = nM * nN; G = G_; c = c_; }
    __host__ __device__ bool next(int i, Unit& u) const {
        const long L = (long)i * G + c; if (L >= nwg) return false;
        int wgid = (int)L; { const int q = nwg / NXCD, r = nwg % NXCD, xcd = wgid % NXCD, off = wgid / NXCD; wgid = (xcd < r ? xcd * (q + 1) : r * (q + 1) + (xcd - r) * q) + off; }
        const int nig = WGM * nN, gid = wgid / nig, fm = gid * WGM, gsz = (nM - fm) < WGM ? (nM - fm) : WGM;
        u.pm = fm + ((wgid % nig) % gsz); u.pn = (wgid % nig) / gsz; return true;
    }
    __device__ __forceinline__ void a_ready(const Unit&) const {}
    __device__ __forceinline__ void done(const Unit&) const {}
};
__device__ __forceinline__ unsigned cvt_pk_bf16(float lo, float hi) { unsigned r; asm volatile("v_cvt_pk_bf16_f32 %0, %1, %2" : "=v"(r) : "v"(lo), "v"(hi)); return r; }
typedef float f32x2 __attribute__((ext_vector_type(2)));
__device__ __forceinline__ float bf_lo(unsigned w) { return __uint_as_float(w << 16); }
__device__ __forceinline__ float bf_hi(unsigned w) { return __uint_as_float(w & 0xffff0000u); }
__device__ __forceinline__ float sigm(float x) { return __builtin_amdgcn_rcpf(1.0f + __expf(-x)); }
__device__ __forceinline__ float gelu_tanh(float x) { const float t = x + 0.044715f * x * x * x; return x * sigm(1.5957691216057308f * t); }

struct EpiAct {
    static constexpr bool PERM = true, AFTER_DRAIN = false;
    bf16_t* O; int ldc; const float* bias; int mode;
    __device__ __forceinline__ void operator()(const f32x4 (&acc)[2][2][4][2], const Unit& u, int wr, int wc, int fr, int fq) const {
        const int row0 = u.pm * BM + wr * 64 + fr; const int colt = u.pn * BM;
        const int col0 = colt + wc * 32 + 8 * fq;
        int act;
        if (mode == 1) act = 3;
        else act = (colt < 1024) ? 0 : (colt < 3072) ? 1 : (colt < 3584) ? 0 : 2;
        f32x4 bv[2][2];
#pragma unroll
        for (int bj = 0; bj < 2; ++bj)
#pragma unroll
            for (int n = 0; n < 2; ++n) bv[bj][n] = *(const f32x4*)(bias + col0 + bj * HALF + 4 * n);
#pragma unroll
        for (int ai = 0; ai < 2; ++ai)
#pragma unroll
            for (int m = 0; m < 4; ++m) { bf16_t* rowp = O + (size_t)(row0 + ai * HALF + m * 16) * ldc + col0;
#pragma unroll
                for (int bj = 0; bj < 2; ++bj) { f32x4 v0 = acc[ai][bj][m][0] + bv[bj][0], v1 = acc[ai][bj][m][1] + bv[bj][1];
                    if (act == 1) {
#pragma unroll
                        for (int j = 0; j < 4; ++j) { v0[j] = gelu_tanh(v0[j]); v1[j] = gelu_tanh(v1[j]); } }
                    else if (act == 2) {
#pragma unroll
                        for (int j = 0; j < 4; ++j) { v0[j] = sigm(v0[j]); v1[j] = sigm(v1[j]); } }
                    else if (act == 3) {
#pragma unroll
                        for (int j = 0; j < 4; ++j) { float a = fmaxf(v0[j], 0.f), b = fmaxf(v1[j], 0.f); v0[j] = a * a; v1[j] = b * b; } }
                    u32x4 w; w.x = cvt_pk_bf16(v0[0], v0[1]); w.y = cvt_pk_bf16(v0[2], v0[3]); w.z = cvt_pk_bf16(v1[0], v1[1]); w.w = cvt_pk_bf16(v1[2], v1[3]);
                    *(u32x4*)(rowp + bj * HALF) = w; } }
    }
};

struct EpiMerge {
    static constexpr bool PERM = true, AFTER_DRAIN = false;
    const bf16_t* G; int ldg; float* MACC; bf16_t* OUT; int mode;
    __device__ __forceinline__ void operator()(const f32x4 (&acc)[2][2][4][2], const Unit& u, int wr, int wc, int fr, int fq) const {
        const int row0 = u.pm * BM + wr * 64 + fr; const int col0 = u.pn * BM + wc * 32 + 8 * fq;
#pragma unroll
        for (int ai = 0; ai < 2; ++ai)
#pragma unroll
            for (int m = 0; m < 4; ++m) { const size_t row = (size_t)(row0 + ai * HALF + m * 16);
#pragma unroll
                for (int bj = 0; bj < 2; ++bj) { const int col = col0 + bj * HALF;
                    const u32x4 g = *(const u32x4*)(G + row * ldg + col);
                    f32x4 v0 = acc[ai][bj][m][0], v1 = acc[ai][bj][m][1];
                    v0[0] *= bf_lo(g.x); v0[1] *= bf_hi(g.x); v0[2] *= bf_lo(g.y); v0[3] *= bf_hi(g.y);
                    v1[0] *= bf_lo(g.z); v1[1] *= bf_hi(g.z); v1[2] *= bf_lo(g.w); v1[3] *= bf_hi(g.w);
                    float* mp = MACC + row * 1024 + col;
                    if (mode > 0) { v0 = v0 + *(const f32x4*)(mp); v1 = v1 + *(const f32x4*)(mp + 4); }
                    if (mode < 2) { *(f32x4*)(mp) = v0; *(f32x4*)(mp + 4) = v1; }
                    else { u32x4 w; w.x = cvt_pk_bf16(v0[0], v0[1]); w.y = cvt_pk_bf16(v0[2], v0[3]); w.z = cvt_pk_bf16(v1[0], v1[1]); w.w = cvt_pk_bf16(v1[2], v1[3]);
                        *(u32x4*)(OUT + row * 1024 + col) = w; } } }
    }
};

struct EpiResid {
    static constexpr bool PERM = false, AFTER_DRAIN = false;
    float* X; const float* bias; float alpha;
    __device__ __forceinline__ void operator()(const f32x4 (&acc)[2][2][4][2], const Unit& u, int wr, int wc, int fr, int fq) const {
        const int row0 = u.pm * BM + wr * 64 + fr, col0 = u.pn * BM + wc * 32 + 4 * fq;
#pragma unroll
        for (int bj = 0; bj < 2; ++bj)
#pragma unroll
            for (int n = 0; n < 2; ++n) { const f32x4 bv = *(const f32x4*)(bias + col0 + bj * HALF + n * 16);
#pragma unroll
                for (int ai = 0; ai < 2; ++ai)
#pragma unroll
                    for (int m = 0; m < 4; ++m) { float* p = X + (size_t)(row0 + ai * HALF + m * 16) * 1024 + col0 + bj * HALF + n * 16;
                        const f32x4 xo = *(const f32x4*)p;
                        *(f32x4*)p = xo * alpha + acc[ai][bj][m][n] + bv; } }
    }
};
template <class Epi, class Sched, bool STAMP = false>
__device__ __forceinline__ void gemm_phase(PG8_LAS unsigned char* lds, const Gemm g, const Sched& S, const Epi& E, unsigned long long* stamps) {
    int tid_ = threadIdx.x; asm volatile("" : "+v"(tid_));
    const int tid = tid_, wid = __builtin_amdgcn_readfirstlane(tid >> 6), lane = tid & 63, wr = wid >> 2, wc = wid & 3, fr = lane & 15, fq = lane >> 4;
    const int K = g.K, nt = K / BK;
    int ts_lo = 0, ts_hi = 0, nts = 0; const unsigned long long rt_entry = STAMP ? (unsigned long long)wall_clock64() : 0ull;
#define PG8_STAMP() do { if (STAMP && wid == 0 && nts < 64) { const unsigned long long _c = (unsigned long long)clock64(); \
        ts_lo = (lane == nts) ? (int)(unsigned)_c : ts_lo; ts_hi = (lane == nts) ? (int)(unsigned)(_c >> 32) : ts_hi; ++nts; } } while (0)
    PG8_STAMP();
    unsigned voffA[2], voffB[2];
#pragma unroll
    for (int i = 0; i < 2; ++i) { int R, C; stage_rc(tid * 16 + i * 8192, R, C); const int Rb = Epi::PERM ? ((R & ~31) + perm32(R & 31)) : R;
        voffA[i] = (unsigned)(R * K + C) * 2u; voffB[i] = (unsigned)(Rb * K + C) * 2u; }
    const size_t kstep = (size_t)(BK * 2);
    const size_t hstep = (size_t)HALF * K * 2;
    const size_t tstep = 2 * hstep;
    const unsigned ldsw = (unsigned)wid * 1024u;
    const int aoff = lds_byte(wr * 64 + fr, fq * 8), boff = lds_byte(wc * 32 + fr, fq * 8);
#define PG8_SA(b, h) (((b) * 2 + (h)) * HTB)
#define PG8_SB(b, h) ((4 + (b) * 2 + (h)) * HTB)
#define PG8_STAGE(bufoff, gbase, voff) do { _Pragma("unroll") for (int _i = 0; _i < 2; ++_i) \
        __builtin_amdgcn_global_load_lds((const unsigned*)((const char*)(gbase) + (voff)[_i]), (PG8_LAS unsigned*)(lds + (bufoff) + ldsw + _i * 8192), 16, 0, 0); } while (0)
#define PG8_LDA(dst, b, h) do { _Pragma("unroll") for (int m = 0; m < 4; ++m) _Pragma("unroll") for (int k = 0; k < 2; ++k) dst[m][k] = *(const PG8_LAS bf16x8*)(lds + PG8_SA(b, h) + aoff + m * 2048 + k * 1024); } while (0)
#define PG8_LDB(dst, b, h) do { _Pragma("unroll") for (int n = 0; n < 2; ++n) _Pragma("unroll") for (int k = 0; k < 2; ++k) dst[n][k] = *(const PG8_LAS bf16x8*)(lds + PG8_SB(b, h) + boff + n * 2048 + k * 1024); } while (0)
#define PG8_MMA(ai, bj, At, Bt) do { __builtin_amdgcn_s_setprio(1); _Pragma("unroll") for (int m = 0; m < 4; ++m) _Pragma("unroll") for (int n = 0; n < 2; ++n) _Pragma("unroll") for (int k = 0; k < 2; ++k) \
        acc[ai][bj][m][n] = __builtin_amdgcn_mfma_f32_16x16x32_bf16(Bt[n][k], At[m][k], acc[ai][bj][m][n], 0, 0, 0); __builtin_amdgcn_s_setprio(0); } while (0)
#define PG8_WAIT_V(n) asm volatile("s_waitcnt vmcnt(" #n ")" ::: "memory")
#define PG8_WAIT_L(n) asm volatile("s_waitcnt lgkmcnt(" #n ")" ::: "memory")
#define PG8_BAR __builtin_amdgcn_s_barrier()
#define PG8_SCHED __builtin_amdgcn_sched_barrier(0)
    Unit cur, nxt; int ui = 0;
    if (!S.next(0, cur)) return;
    f32x4 acc[2][2][4][2];
#pragma unroll
    for (int a = 0; a < 2; ++a)
#pragma unroll
        for (int b = 0; b < 2; ++b)
#pragma unroll
            for (int m = 0; m < 4; ++m)
#pragma unroll
                for (int n = 0; n < 2; ++n) acc[a][b][m][n] = (f32x4){0.f, 0.f, 0.f, 0.f};
    bf16x8 At[4][2], B0[2][2], B1[2][2];
    const char* cA = (const char*)g.A + (size_t)cur.pm * tstep; const char* cB = (const char*)g.Bt + (size_t)cur.pn * tstep;
    S.a_ready(cur);
    PG8_STAGE(PG8_SB(0, 0), cB, voffB); PG8_STAGE(PG8_SA(0, 0), cA, voffA); PG8_STAGE(PG8_SB(0, 1), cB + hstep, voffB); PG8_STAGE(PG8_SA(0, 1), cA + hstep, voffA);
    if (wr == 1) PG8_BAR;
    PG8_WAIT_V(4); PG8_BAR;
    PG8_STAGE(PG8_SB(1, 0), cB + kstep, voffB); PG8_STAGE(PG8_SA(1, 0), cA + kstep, voffA); PG8_STAGE(PG8_SB(1, 1), cB + hstep + kstep, voffB);
    PG8_WAIT_V(6); PG8_BAR;
    PG8_STAMP();
    for (;;) {
        const bool has_next = S.next(ui + 1, nxt);
        const char* nA = has_next ? (const char*)g.A + (size_t)nxt.pm * tstep : cA; const char* nB = has_next ? (const char*)g.Bt + (size_t)nxt.pn * tstep : cB;
        for (int t = 0; t < nt; t += 2) {
            const bool last = (t == nt - 2);
            const char* a1 = cA + (size_t)(t + 1) * kstep;
            const char* a2 = last ? nA : cA + (size_t)(t + 2) * kstep; const char* b2 = last ? nB : cB + (size_t)(t + 2) * kstep;
            const char* a3 = a2 + kstep; const char* b3 = b2 + kstep;
            if (last && has_next) S.a_ready(nxt);
            PG8_LDB(B0, 0, 0); PG8_SCHED; PG8_LDA(At, 0, 0); PG8_STAGE(PG8_SA(1, 1), a1 + hstep, voffA);
            PG8_WAIT_L(8); PG8_BAR; PG8_WAIT_L(0); PG8_MMA(0, 0, At, B0); PG8_BAR; PG8_SCHED;
            PG8_LDB(B1, 0, 1); PG8_STAGE(PG8_SB(0, 0), b2, voffB);
            PG8_BAR; PG8_WAIT_L(0); PG8_MMA(0, 1, At, B1); PG8_BAR;
            PG8_LDA(At, 0, 1); PG8_STAGE(PG8_SA(0, 0), a2, voffA);
            PG8_BAR; PG8_WAIT_L(0); PG8_MMA(1, 0, At, B0); PG8_BAR; PG8_SCHED;
            PG8_STAGE(PG8_SB(0, 1), b2 + hstep, voffB);
            PG8_WAIT_V(6); PG8_BAR; PG8_MMA(1, 1, At, B1); PG8_BAR;
            PG8_LDB(B0, 1, 0); PG8_SCHED; PG8_LDA(At, 1, 0); PG8_STAGE(PG8_SA(0, 1), a2 + hstep, voffA);
            PG8_WAIT_L(8); PG8_BAR; PG8_WAIT_L(0); PG8_MMA(0, 0, At, B0); PG8_BAR; PG8_SCHED;
            PG8_LDB(B1, 1, 1); PG8_STAGE(PG8_SB(1, 0), b3, voffB);
            PG8_BAR; PG8_WAIT_L(0); PG8_MMA(0, 1, At, B1); PG8_BAR;
            PG8_LDA(At, 1, 1); PG8_STAGE(PG8_SA(1, 0), a3, voffA);
            PG8_BAR; PG8_WAIT_L(0); PG8_MMA(1, 0, At, B0); PG8_BAR; PG8_SCHED;
            PG8_STAGE(PG8_SB(1, 1), b3 + hstep, voffB);
            PG8_WAIT_V(6); PG8_BAR; PG8_MMA(1, 1, At, B1); PG8_BAR;
        }
        PG8_STAMP();
        if constexpr (!Epi::AFTER_DRAIN) { E(acc, cur, wr, wc, fr, fq); S.done(cur); }
        PG8_STAMP();
        if (!has_next) break;
#pragma unroll
        for (int a = 0; a < 2; ++a)
#pragma unroll
            for (int b = 0; b < 2; ++b)
#pragma unroll
                for (int m = 0; m < 4; ++m)
#pragma unroll
                    for (int n = 0; n < 2; ++n) acc[a][b][m][n] = (f32x4){0.f, 0.f, 0.f, 0.f};
        cur = nxt; cA = nA; cB = nB; ++ui;
    }
    PG8_WAIT_V(0);
    if (wr == 0) PG8_BAR;
    PG8_BAR;
    if constexpr (Epi::AFTER_DRAIN) { E.fused(acc, cur, wr, wc, fr, fq, lds, wid, lane); S.done(cur); }
    PG8_STAMP();
    if (STAMP && wid == 0) { stamps[lane] = lane < nts ? (((unsigned long long)(unsigned)ts_hi << 32) | (unsigned)ts_lo) : 0ull;
        if (lane == 62) stamps[62] = rt_entry; if (lane == 63) stamps[63] = (unsigned long long)wall_clock64(); }
#undef PG8_STAMP
#undef PG8_SA
#undef PG8_SB
#undef PG8_STAGE
#undef PG8_LDA
#undef PG8_LDB
#undef PG8_MMA
#undef PG8_WAIT_V
#undef PG8_WAIT_L
#undef PG8_BAR
#undef PG8_SCHED
}
}

using pg8::bf16_t; using pg8::bf16x8; using pg8::f32x4; using pg8::u32x4; using pg8::f32x2;
using pg8::bf_lo; using pg8::bf_hi; using pg8::sigm; using pg8::cvt_pk_bf16;
#define LAS __attribute__((address_space(3)))

constexpr int D = 1024, DIN = 7168, DFF = 4096, DEPTH = 2;
constexpr int TG = 16384, NGRP = 3;
constexpr int OFF_RG_X = 0, OFF_RG_G = 1024, OFF_SG = 2048, OFF_CC = 3072, OFF_GATE = 4096;
constexpr float LN_EPS = 1e-5f;
constexpr float ALPHA = 1.41421356237309515f;
constexpr int NT = 512;
constexpr int LDS_BYTES = 131072 + 4096;
#ifndef REP_P1
#define REP_P1 1
#endif
#ifndef REP_P2
#define REP_P2 1
#endif
#ifndef REP_P5
#define REP_P5 1
#endif

constexpr size_t SZ_WIN = (size_t)DIN * D * 2, SZ_WBA = (size_t)D * D * 2, SZ_WBB = (size_t)D * 512 * 2, SZ_WBC = SZ_WBB, SZ_WO = SZ_WBA,
                 SZ_FF1 = (size_t)DFF * D * 2, SZ_FF2 = SZ_FF1, SZ_RG = (size_t)2 * 8 * 128 * 128 * 2, SZ_SGW = (size_t)4 * 128 * 128 * 2;
constexpr size_t LW_WIN = 0, LW_WBA = LW_WIN + SZ_WIN, LW_WBB = LW_WBA + SZ_WBA, LW_WBC = LW_WBB + SZ_WBB, LW_WO = LW_WBC + SZ_WBC,
                 LW_FF1 = LW_WO + SZ_WO, LW_FF2 = LW_FF1 + SZ_FF1, LW_RGA = LW_FF2 + SZ_FF2, LW_RGX = LW_RGA + SZ_RG, LW_SGW = LW_RGX + SZ_RG,
                 LW_END = LW_SGW + SZ_SGW;
constexpr size_t WS_W = 0, WS_XB = WS_W + DEPTH * LW_END, WS_PROJ = WS_XB + (size_t)TG * D * 2, WS_BA = WS_PROJ + (size_t)TG * DIN * 2,
                 WS_BB = WS_BA + (size_t)TG * D * 2, WS_BC = WS_BB + (size_t)TG * 512 * 2, WS_MACC = WS_BC + (size_t)TG * 512 * 2,
                 WS_AGG = WS_MACC + (size_t)TG * D * 4, WS_END = WS_AGG + (size_t)128 * 2 * 2 * 1024 * 4;

struct Args { const float* in[34]; float* out; unsigned char* ws; };

struct Ctx {
    float* out; unsigned char* ws;
    LAS unsigned char* lds;
    int tid, lane, wave, G, bid;
};

__device__ __forceinline__ int opaque(int x) { asm volatile("" : "+v"(x)); return x; }
__device__ __forceinline__ unsigned f2bf(float f) { unsigned u = __float_as_uint(f); return (u + 0x7fffu + ((u >> 16) & 1u)) >> 16; }
__device__ __forceinline__ float bf2f(bf16_t b) { return __uint_as_float(((unsigned)b) << 16); }
__device__ __forceinline__ float wave_sum(float v) {
#pragma unroll
    for (int o = 1; o < 64; o <<= 1) v += __shfl_xor(v, o);
    return v;
}

__device__ __forceinline__ void transpose_item(const float* W, int K, int N, bf16_t* WT, LAS float* scr, int item, int lane) {
    const int nblk = N / 32, kb = item / nblk, nb = item % nblk, k0 = 64 * kb, n0 = 32 * nb;
#pragma unroll 8
    for (int i = 0; i < 32; ++i) { const int kk = 2 * i + (lane >> 5); scr[kk * 33 + (lane & 31)] = W[(size_t)(k0 + kk) * N + n0 + (lane & 31)]; }
    asm volatile("s_waitcnt lgkmcnt(0)" ::: "memory");
    const int c = lane & 7;
#pragma unroll
    for (int j = 0; j < 4; ++j) { const int n = (lane >> 3) + 8 * j; const LAS float* s = scr + (8 * c) * 33 + n;
        u32x4 o; o.x = f2bf(s[0 * 33]) | (f2bf(s[1 * 33]) << 16); o.y = f2bf(s[2 * 33]) | (f2bf(s[3 * 33]) << 16);
        o.z = f2bf(s[4 * 33]) | (f2bf(s[5 * 33]) << 16); o.w = f2bf(s[6 * 33]) | (f2bf(s[7 * 33]) << 16);
        *(u32x4*)(WT + (size_t)(n0 + n) * K + k0 + 8 * c) = o; }
    asm volatile("s_waitcnt lgkmcnt(0)" ::: "memory");
}
__device__ __forceinline__ void transpose_job(const Ctx& C, const float* W, int K, int N, int nmat, bf16_t* WT) {
    const int tid = opaque(C.tid), lane = tid & 63, wave = __builtin_amdgcn_readfirstlane(tid >> 6);
    LAS float* scr = (LAS float*)(C.lds + wave * 8704);
    const int per = (K / 64) * (N / 32), total = per * nmat;
    const int gw = C.bid * 8 + wave, NGW = C.G * 8;
    for (int it = gw; it < total; it += NGW) { const int mat = it / per, r = it % per;
        transpose_item(W + (size_t)mat * K * N, K, N, WT + (size_t)mat * K * N, scr, r, lane); }
}
__device__ __forceinline__ void convert_job(const Ctx& C, const float* W, size_t n, bf16_t* O) {
    const size_t gt = (size_t)C.bid * NT + opaque(C.tid), NGT = (size_t)C.G * NT;
    for (size_t i = gt * 4; i < n; i += NGT * 4) { const f32x4 v = *(const f32x4*)(W + i);
        unsigned long long o = (unsigned long long)(f2bf(v[0]) | (f2bf(v[1]) << 16)) | ((unsigned long long)(f2bf(v[2]) | (f2bf(v[3]) << 16)) << 32);
        *(unsigned long long*)(O + i) = o; }
}
__device__ __forceinline__ void prologue_weights(const Ctx& C, const Args& AR) {
    for (int l = 0; l < DEPTH; ++l) {
        unsigned char* wl = C.ws + WS_W + (size_t)l * LW_END;
        transpose_job(C, AR.in[4] + (size_t)l * D * DIN, D, DIN, 1, (bf16_t*)(wl + LW_WIN));
        transpose_job(C, AR.in[21] + (size_t)l * D * D, D, D, 1, (bf16_t*)(wl + LW_WBA));
        transpose_job(C, AR.in[22] + (size_t)l * 512 * D, 512, D, 1, (bf16_t*)(wl + LW_WBB));
        transpose_job(C, AR.in[23] + (size_t)l * 512 * D, 512, D, 1, (bf16_t*)(wl + LW_WBC));
        transpose_job(C, AR.in[24] + (size_t)l * D * D, D, D, 1, (bf16_t*)(wl + LW_WO));
        transpose_job(C, AR.in[28] + (size_t)l * D * DFF, D, DFF, 1, (bf16_t*)(wl + LW_FF1));
        transpose_job(C, AR.in[30] + (size_t)l * DFF * D, DFF, D, 1, (bf16_t*)(wl + LW_FF2));
        transpose_job(C, AR.in[8] + (size_t)l * 16 * 16384, 128, 128, 16, (bf16_t*)(wl + LW_RGA));
        transpose_job(C, AR.in[10] + (size_t)l * 16 * 16384, 128, 128, 16, (bf16_t*)(wl + LW_RGX));
        convert_job(C, AR.in[15] + (size_t)l * 4 * 16384, (size_t)4 * 16384, (bf16_t*)(wl + LW_SGW));
    }
}

__device__ __forceinline__ void ln_rows(const Ctx& C, const float* src, float* dstf, bf16_t* dstb, const float* g, const float* b, int nrows) {
    const int tid = opaque(C.tid), lane = tid & 63, wave = __builtin_amdgcn_readfirstlane(tid >> 6);
    const int gw = C.bid * 8 + wave, NGW = C.G * 8;
    f32x4 gv[4], bv[4];
#pragma unroll
    for (int j = 0; j < 4; ++j) { gv[j] = *(const f32x4*)(g + 4 * lane + 256 * j); bv[j] = *(const f32x4*)(b + 4 * lane + 256 * j); }
    for (int r = gw; r < nrows; r += NGW) {
        const float* xr = src + (size_t)r * D + 4 * lane;
        f32x4 v[4]; float s = 0.f;
#pragma unroll
        for (int j = 0; j < 4; ++j) { v[j] = *(const f32x4*)(xr + 256 * j); s += (v[j][0] + v[j][1]) + (v[j][2] + v[j][3]); }
        const float mean = wave_sum(s) * (1.f / D); float s2 = 0.f;
#pragma unroll
        for (int j = 0; j < 4; ++j) { v[j] = v[j] - mean; s2 += (v[j][0] * v[j][0] + v[j][1] * v[j][1]) + (v[j][2] * v[j][2] + v[j][3] * v[j][3]); }
        const float rstd = 1.f / sqrtf(wave_sum(s2) * (1.f / D) + LN_EPS);
#pragma unroll
        for (int j = 0; j < 4; ++j) { const f32x4 y = v[j] * rstd * gv[j] + bv[j];
            *(f32x4*)(dstf + (size_t)r * D + 4 * lane + 256 * j) = y;
            if (dstb) { unsigned long long o = (unsigned long long)cvt_pk_bf16(y[0], y[1]) | ((unsigned long long)cvt_pk_bf16(y[2], y[3]) << 32);
                *(unsigned long long*)(dstb + (size_t)r * D + 4 * lane + 256 * j) = o; } }
    }
}

__device__ __forceinline__ float softplusf_(float x) { return fmaxf(x, 0.f) + log1pf(__expf(-fabsf(x))); }
__device__ __forceinline__ float expm1_poly(float x) {
    return x * (1.f + x * (0.5f + x * (0.16666667f + x * (0.041666668f + x * (0.0083333338f + x * (0.0013888889f + x * 0.00019841270f))))));
}

template <int PASS>
__device__ __forceinline__ void rg_unit(const Ctx& C, const Args& AR, int layer, int grp, int chunk, int head) {
    const int tid = opaque(C.tid), lane = tid & 63, wave = __builtin_amdgcn_readfirstlane(tid >> 6), fr = lane & 15, fq = lane >> 4;
    const int L = (grp == 0) ? 16384 : 2048;
    const int t0 = chunk * 128, s0 = (t0 / L) * L, s1 = s0 + L;
    const bf16_t* P = (const bf16_t*)(C.ws + WS_PROJ);
    LAS bf16_t* xa = (LAS bf16_t*)C.lds;
    LAS float* ht = (LAS float*)(C.lds + 36864);
    LAS float* lbk = (LAS float*)(C.lds + 36864 + 69632);
    const unsigned char* wl = C.ws + WS_W + (size_t)layer * LW_END;
    float* agg = (float*)(C.ws + WS_AGG);
    if (PASS == 2) {
        const int lch = tid & 127, part = tid >> 7;
        const int cfirst = s0 / 128, clast = s1 / 128 - 1;
        const float* ap = agg + head * 128 + lch;
        {   const int len = chunk - cfirst, cb = cfirst + (len * part) / 4, ce = cfirst + (len * (part + 1)) / 4;
            float A = 1.f, B = 0.f;
#pragma unroll 16
            for (int c = cb; c < ce; ++c) { const float pj = ap[(size_t)(c * 2 + 0) * 2048], ej = ap[(size_t)(c * 2 + 0) * 2048 + 1024]; A = pj * A; B = pj * B + ej; }
            lbk[((0 * 4 + part) * 2 + 0) * 128 + lch] = A; lbk[((0 * 4 + part) * 2 + 1) * 128 + lch] = B; }
        {   const int len = clast - chunk, cb = clast - (len * part) / 4, ce = clast - (len * (part + 1)) / 4;
            float A = 1.f, B = 0.f;
#pragma unroll 16
            for (int c = cb; c > ce; --c) { const float pj = ap[(size_t)(c * 2 + 1) * 2048], ej = ap[(size_t)(c * 2 + 1) * 2048 + 1024]; A = pj * A; B = pj * B + ej; }
            lbk[((1 * 4 + part) * 2 + 0) * 128 + lch] = A; lbk[((1 * 4 + part) * 2 + 1) * 128 + lch] = B; }
    }
    {
        const float* cw = AR.in[6] + (size_t)layer * 4 * 1024 + head * 128;
        const float* cb = AR.in[7] + (size_t)layer * 1024 + head * 128;
#pragma unroll 1
        for (int item = tid; item < 2048; item += NT) {
            const int t = item >> 4, c8 = (item & 15) * 8;
            f32x4 o0 = *(const f32x4*)(cb + c8), o1 = *(const f32x4*)(cb + c8 + 4);
#pragma unroll
            for (int k = 0; k < 4; ++k) { const int tt = t0 + t - 2 + k;
                if (tt >= s0 && tt < s1) {
                    const u32x4 xv = *(const u32x4*)(P + (size_t)tt * DIN + OFF_RG_X + head * 128 + c8);
                    const f32x4 w0 = *(const f32x4*)(cw + k * 1024 + c8), w1 = *(const f32x4*)(cw + k * 1024 + c8 + 4);
                    o0[0] += bf_lo(xv.x) * w0[0]; o0[1] += bf_hi(xv.x) * w0[1]; o0[2] += bf_lo(xv.y) * w0[2]; o0[3] += bf_hi(xv.y) * w0[3];
                    o1[0] += bf_lo(xv.z) * w1[0]; o1[1] += bf_hi(xv.z) * w1[1]; o1[2] += bf_lo(xv.w) * w1[2]; o1[3] += bf_hi(xv.w) * w1[3]; } }
            u32x4 w; w.x = cvt_pk_bf16(o0[0], o0[1]); w.y = cvt_pk_bf16(o0[2], o0[3]); w.z = cvt_pk_bf16(o1[0], o1[1]); w.w = cvt_pk_bf16(o1[2], o1[3]);
            *(LAS u32x4*)(xa + t * 136 + c8) = w; }
    }
    __syncthreads();
    const int chl = wave * 16 + fr;
    const int ch = head * 128 + chl;
    f32x4 hsum[8];
#pragma unroll
    for (int d = 0; d < 2; ++d) {
        const bf16_t* Wa = (const bf16_t*)(wl + LW_RGA) + (size_t)(d * 8 + head) * 16384;
        const bf16_t* Wx = (const bf16_t*)(wl + LW_RGX) + (size_t)(d * 8 + head) * 16384;
        bf16x8 Ba[4], Bx[4];
#pragma unroll
        for (int k = 0; k < 4; ++k) { Ba[k] = *(const bf16x8*)(Wa + (size_t)chl * 128 + k * 32 + fq * 8); Bx[k] = *(const bf16x8*)(Wx + (size_t)chl * 128 + k * 32 + fq * 8); }
        const int pidx = (layer * 2 + d) * 1024 + ch;
        const float ba = AR.in[9][pidx], bx = AR.in[11][pidx], lam = AR.in[12][pidx];
        const float logac = -8.0f * softplusf_(-lam);
        float H = 0.f, Pp = 1.f;
        if (PASS == 2) {
#pragma unroll
            for (int p = 0; p < 4; ++p) H = lbk[((d * 4 + p) * 2 + 0) * 128 + chl] * H + lbk[((d * 4 + p) * 2 + 1) * 128 + chl];
        }
#pragma unroll
        for (int mm = 0; mm < 8; ++mm) {
            const int m = (d == 0) ? mm : 7 - mm;
            f32x4 ar = (f32x4){0.f, 0.f, 0.f, 0.f}, ai = (f32x4){0.f, 0.f, 0.f, 0.f};
#pragma unroll
            for (int k = 0; k < 4; ++k) { const bf16x8 A = *(const LAS bf16x8*)(xa + (m * 16 + fr) * 136 + k * 32 + fq * 8);
                ar = __builtin_amdgcn_mfma_f32_16x16x32_bf16(A, Ba[k], ar, 0, 0, 0);
                ai = __builtin_amdgcn_mfma_f32_16x16x32_bf16(A, Bx[k], ai, 0, 0, 0); }
            float a[4], u[4];
#pragma unroll
            for (int j = 0; j < 4; ++j) {
                const float xr = fminf(fmaxf(ar[j] + ba, -30.f), 30.f), xi = fminf(fmaxf(ai[j] + bx, -30.f), 30.f);
                const float d1 = 1.0f + __expf(-xr), d2 = 1.0f + __expf(-xi);
                const float inv = __builtin_amdgcn_rcpf(d1 * d2);
                const float r = d2 * inv, ig = d1 * inv;
                const float la = r * logac; const float av = __expf(la); const float t2 = 2.0f * la;
                const float om = (t2 > -0.25f) ? -expm1_poly(t2) : (1.0f - av * av);
                const float xv = bf2f(xa[(m * 16 + fq * 4 + j) * 136 + chl]);
                a[j] = av; u[j] = __builtin_amdgcn_sqrtf(fmaxf(om, 0.f)) * (ig * xv); }
            const float a0 = a[0], a1 = a[1], a2 = a[2], a3 = a[3], u0 = u[0], u1 = u[1], u2 = u[2], u3 = u[3];
            const float Aloc = (a0 * a1) * (a2 * a3);
            const float Bloc = (d == 0) ? (((u0 * a1 + u1) * a2 + u2) * a3 + u3) : (((u3 * a2 + u2) * a1 + u1) * a0 + u0);
            const float A0 = __shfl(Aloc, fr), B0 = __shfl(Bloc, fr), A1 = __shfl(Aloc, fr + 16), B1 = __shfl(Bloc, fr + 16);
            const float A2 = __shfl(Aloc, fr + 32), B2 = __shfl(Bloc, fr + 32), A3 = __shfl(Aloc, fr + 48), B3 = __shfl(Bloc, fr + 48);
            float hin, S4;
            if (d == 0) { const float S1 = A0 * H + B0, S2 = A1 * S1 + B1, S3 = A2 * S2 + B2; S4 = A3 * S3 + B3;
                hin = (fq == 0) ? H : (fq == 1) ? S1 : (fq == 2) ? S2 : S3; }
            else { const float S1 = A3 * H + B3, S2 = A2 * S1 + B2, S3 = A1 * S2 + B1; S4 = A0 * S3 + B0;
                hin = (fq == 3) ? H : (fq == 2) ? S1 : (fq == 1) ? S2 : S3; }
            if (PASS == 2) {
                if (d == 0) { const float h0 = a0 * hin + u0, h1 = a1 * h0 + u1, h2 = a2 * h1 + u2, h3 = a3 * h2 + u3; hsum[m] = (f32x4){h0, h1, h2, h3}; }
                else { const float h3 = a3 * hin + u3, h2 = a2 * h3 + u2, h1 = a1 * h2 + u1, h0 = a0 * h1 + u0; hsum[m] = hsum[m] + (f32x4){h0, h1, h2, h3}; }
            } else { Pp *= (A0 * A1) * (A2 * A3); }
            H = S4;
            __builtin_amdgcn_sched_barrier(0);
        }
        if (PASS == 1) { if (fq == 0) { agg[(size_t)(chunk * 2 + d) * 2048 + ch] = Pp; agg[(size_t)(chunk * 2 + d) * 2048 + 1024 + ch] = H; } }
    }
    if (PASS == 2) {
#pragma unroll
        for (int m = 0; m < 8; ++m)
#pragma unroll
            for (int j = 0; j < 4; ++j) ht[(m * 16 + fq * 4 + j) * 132 + chl] = hsum[m][j];
        __syncthreads();
        bf16_t* BA = (bf16_t*)(C.ws + WS_BA);
#pragma unroll
        for (int it = 0; it < 4; ++it) { const int item = tid + it * NT, t = item >> 4, c8 = (item & 15) * 8;
            const f32x4 h0 = *(const LAS f32x4*)(ht + t * 132 + c8), h1 = *(const LAS f32x4*)(ht + t * 132 + c8 + 4);
            const u32x4 g = *(const u32x4*)(P + (size_t)(t0 + t) * DIN + OFF_RG_G + head * 128 + c8);
            u32x4 w; w.x = cvt_pk_bf16(h0[0] * bf_lo(g.x), h0[1] * bf_hi(g.x)); w.y = cvt_pk_bf16(h0[2] * bf_lo(g.y), h0[3] * bf_hi(g.y));
            w.z = cvt_pk_bf16(h1[0] * bf_lo(g.z), h1[1] * bf_hi(g.z)); w.w = cvt_pk_bf16(h1[2] * bf_lo(g.w), h1[3] * bf_hi(g.w));
            *(u32x4*)(BA + (size_t)(t0 + t) * 1024 + head * 128 + c8) = w; }
    }
    __syncthreads();
}

__device__ __forceinline__ void sg_unit(const Ctx& C, const Args& AR, int layer, int chunk, int g) {
    const int tid = opaque(C.tid), lane = tid & 63, wave = __builtin_amdgcn_readfirstlane(tid >> 6), fr = lane & 15, fq = lane >> 4;
    const int t0 = chunk * 128;
    const bf16_t* P = (const bf16_t*)(C.ws + WS_PROJ);
    LAS bf16_t* Vt = (LAS bf16_t*)C.lds;
    const unsigned char* wl = C.ws + WS_W + (size_t)layer * LW_END;
    {
        const int q = tid >> 2, sub = tid & 3;
        const bf16_t* vrow = P + (size_t)(t0 + q) * DIN + OFF_SG + 512;
        float s = 0.f, ss = 0.f;
#pragma unroll
        for (int i = 0; i < 16; ++i) { const u32x4 w = *(const u32x4*)(vrow + sub * 128 + i * 8);
            const float v0 = bf_lo(w.x), v1 = bf_hi(w.x), v2 = bf_lo(w.y), v3 = bf_hi(w.y), v4 = bf_lo(w.z), v5 = bf_hi(w.z), v6 = bf_lo(w.w), v7 = bf_hi(w.w);
            s += ((v0 + v1) + (v2 + v3)) + ((v4 + v5) + (v6 + v7));
            ss += ((v0 * v0 + v1 * v1) + (v2 * v2 + v3 * v3)) + ((v4 * v4 + v5 * v5) + (v6 * v6 + v7 * v7)); }
        s += __shfl_xor(s, 1); s += __shfl_xor(s, 2); ss += __shfl_xor(ss, 1); ss += __shfl_xor(ss, 2);
        const float mean = s * (1.f / 512.f); const float var = fmaxf(ss * (1.f / 512.f) - mean * mean, 0.f);
        const float rstd = 1.f / sqrtf(var + LN_EPS);
        const float* lg = AR.in[13] + (size_t)layer * 512 + g * 128; const float* lb = AR.in[14] + (size_t)layer * 512 + g * 128;
#pragma unroll
        for (int i = 0; i < 4; ++i) { const int d0 = sub * 32 + i * 8;
            const u32x4 w = *(const u32x4*)(vrow + g * 128 + d0);
            const f32x4 g0 = *(const f32x4*)(lg + d0), g1 = *(const f32x4*)(lg + d0 + 4), b0 = *(const f32x4*)(lb + d0), b1 = *(const f32x4*)(lb + d0 + 4);
            float v[8] = {bf_lo(w.x), bf_hi(w.x), bf_lo(w.y), bf_hi(w.y), bf_lo(w.z), bf_hi(w.z), bf_lo(w.w), bf_hi(w.w)};
#pragma unroll
            for (int e = 0; e < 8; ++e) { const float gg = (e < 4) ? g0[e & 3] : g1[e & 3], bb = (e < 4) ? b0[e & 3] : b1[e & 3];
                Vt[(d0 + e) * 136 + q] = (bf16_t)f2bf((v[e] - mean) * rstd * gg + bb); } }
    }
    __syncthreads();
    {
        const bf16_t* W = (const bf16_t*)(wl + LW_SGW) + (size_t)g * 16384;
        bf16x8 A[4];
#pragma unroll
        for (int k = 0; k < 4; ++k) A[k] = *(const bf16x8*)(W + (size_t)(wave * 16 + fr) * 128 + k * 32 + fq * 8);
        const float* sgb = AR.in[16] + (size_t)(layer * 4 + g) * 128;
        bf16_t* BB = (bf16_t*)(C.ws + WS_BB);
#pragma unroll
        for (int n = 0; n < 8; ++n) { f32x4 acc = (f32x4){0.f, 0.f, 0.f, 0.f};
#pragma unroll
            for (int k = 0; k < 4; ++k) { const bf16x8 B = *(const LAS bf16x8*)(Vt + (n * 16 + fr) * 136 + k * 32 + fq * 8);
                acc = __builtin_amdgcn_mfma_f32_16x16x32_bf16(A[k], B, acc, 0, 0, 0); }
#pragma unroll
            for (int j = 0; j < 4; ++j) { const int p = wave * 16 + fq * 4 + j; const size_t t = (size_t)(t0 + p);
                const float sp = acc[j] + sgb[p];
                const float uu = bf2f(P[t * DIN + OFF_SG + g * 128 + n * 16 + fr]);
                BB[t * 512 + g * 128 + n * 16 + fr] = (bf16_t)f2bf(uu * sp); } }
    }
    __syncthreads();
}

__device__ __forceinline__ void cc_unit(const Ctx& C, const Args& AR, int layer, int grp, int tile) {
    const int tid = opaque(C.tid), lane = tid & 63, wave = __builtin_amdgcn_readfirstlane(tid >> 6);
    const int L = (grp == 0) ? 16384 : 2048;
    const int t0 = tile * 64, s0 = (t0 / L) * L, s1 = s0 + L;
    const bf16_t* P = (const bf16_t*)(C.ws + WS_PROJ);
    LAS bf16_t* cbuf = (LAS bf16_t*)C.lds;
    LAS float* part = (LAS float*)(C.lds + 94 * 1024);
#pragma unroll 1
    for (int item = tid; item < 94 * 64; item += NT) {
        const int r = item >> 6, c8 = (item & 63) * 8, tt = t0 - 15 + r;
        u32x4 w = (u32x4){0u, 0u, 0u, 0u};
        if (tt >= s0 && tt < s1) {
            const u32x4 a = *(const u32x4*)(P + (size_t)tt * DIN + OFF_CC + c8), sg = *(const u32x4*)(P + (size_t)tt * DIN + OFF_CC + 512 + c8);
            w.x = cvt_pk_bf16(bf_lo(a.x) * bf_lo(sg.x), bf_hi(a.x) * bf_hi(sg.x)); w.y = cvt_pk_bf16(bf_lo(a.y) * bf_lo(sg.y), bf_hi(a.y) * bf_hi(sg.y));
            w.z = cvt_pk_bf16(bf_lo(a.z) * bf_lo(sg.z), bf_hi(a.z) * bf_hi(sg.z)); w.w = cvt_pk_bf16(bf_lo(a.w) * bf_lo(sg.w), bf_hi(a.w) * bf_hi(sg.w)); }
        *(LAS u32x4*)(cbuf + r * 512 + c8) = w; }
    __syncthreads();
    const int cp = tid & 255, half = tid >> 8, ch0 = 2 * cp;
    const float* cw = AR.in[17] + (size_t)layer * 31 * 512 + ch0;
    const f32x2 cb = *(const f32x2*)(AR.in[18] + (size_t)layer * 512 + ch0);
    f32x2 y[32];
#pragma unroll
    for (int tt = 0; tt < 32; ++tt) y[tt] = cb;
#pragma unroll 1
    for (int k = 0; k < 31; ++k) {
        const f32x2 w = *(const f32x2*)(cw + k * 512);
        const LAS unsigned* base = (const LAS unsigned*)(cbuf + (half * 32 + k) * 512 + ch0);
#pragma unroll
        for (int tt = 0; tt < 32; ++tt) { const unsigned c = base[tt * 256]; y[tt][0] += bf_lo(c) * w[0]; y[tt][1] += bf_hi(c) * w[1]; }
    }
#pragma unroll
    for (int tt = 0; tt < 32; ++tt) {
        float s = y[tt][0] + y[tt][1], ss = y[tt][0] * y[tt][0] + y[tt][1] * y[tt][1];
        s = wave_sum(s); ss = wave_sum(ss);
        if (lane == 0) { part[((half * 32 + tt) * 4 + (wave & 3)) * 2] = s; part[((half * 32 + tt) * 4 + (wave & 3)) * 2 + 1] = ss; }
    }
    __syncthreads();
    const f32x2 lg = *(const f32x2*)(AR.in[19] + (size_t)layer * 512 + ch0), lb = *(const f32x2*)(AR.in[20] + (size_t)layer * 512 + ch0);
    bf16_t* BC = (bf16_t*)(C.ws + WS_BC);
#pragma unroll
    for (int tt = 0; tt < 32; ++tt) {
        const LAS float* pp = part + (half * 32 + tt) * 8;
        const float s = (pp[0] + pp[2]) + (pp[4] + pp[6]), ss = (pp[1] + pp[3]) + (pp[5] + pp[7]);
        const float mean = s * (1.f / 512.f); const float var = fmaxf(ss * (1.f / 512.f) - mean * mean, 0.f);
        const float rstd = 1.f / sqrtf(var + LN_EPS);
        const float z0 = (y[tt][0] - mean) * rstd * lg[0] + lb[0], z1 = (y[tt][1] - mean) * rstd * lg[1] + lb[1];
        *(unsigned*)(BC + (size_t)(t0 + half * 32 + tt) * 512 + ch0) = cvt_pk_bf16(z0 * sigm(z0), z1 * sigm(z1));
    }
    __syncthreads();
}
template <class Epi>
__device__ __forceinline__ void run_gemm(const Ctx& C, const bf16_t* A, const bf16_t* Bt, int M, int N, int K, const Epi& E) {
    pg8::Gemm g{A, Bt, M, N, K}; pg8::StaticOrder S; S.init(M, N, C.G, C.bid);
    pg8::gemm_phase<Epi, pg8::StaticOrder, false>(C.lds, g, S, E, nullptr);
}

__global__ void __launch_bounds__(NT, 2) fwd_kernel(Args args) {
    extern __shared__ __attribute__((aligned(16))) unsigned char shm[];
    cg::grid_group grid = cg::this_grid();
    Ctx C; C.out = args.out; C.ws = args.ws; C.lds = (LAS unsigned char*)shm;
    C.tid = threadIdx.x; C.lane = C.tid & 63; C.wave = __builtin_amdgcn_readfirstlane(C.tid >> 6); C.G = gridDim.x; C.bid = blockIdx.x;

    bf16_t* XB = (bf16_t*)(C.ws + WS_XB);
    bf16_t* PROJ = (bf16_t*)(C.ws + WS_PROJ);
    bf16_t* HID = PROJ;
    bf16_t* BA = (bf16_t*)(C.ws + WS_BA); bf16_t* BB = (bf16_t*)(C.ws + WS_BB); bf16_t* BC = (bf16_t*)(C.ws + WS_BC);
    float* MACC = (float*)(C.ws + WS_MACC);
    bf16_t* MERGED = XB;

    prologue_weights(C, args);
    ln_rows(C, args.in[0], C.out, XB, args.in[2], args.in[3], TG);
    grid.sync();

#pragma unroll 1
    for (int grp = 0; grp < NGRP; ++grp) {
        float* X = C.out + (size_t)grp * TG * D;
#pragma unroll 1
        for (int layer = 0; layer < DEPTH; ++layer) {
            const unsigned char* wl = C.ws + WS_W + (size_t)layer * LW_END;
#pragma unroll 1
            for (int rep = 0; rep < REP_P1; ++rep) {
            { pg8::EpiAct E{PROJ, DIN, args.in[5] + (size_t)layer * DIN, 0};
              run_gemm(C, XB, (const bf16_t*)(wl + LW_WIN), TG, DIN, D, E); }
            grid.sync(); }
#pragma unroll 1
            for (int rep = 0; rep < REP_P2; ++rep) {
#pragma unroll 1
            for (int u = C.bid; u < 1792; u += C.G) {
                if (u < 1024) rg_unit<1>(C, args, layer, grp, u >> 3, u & 7);
                else if (u < 1536) sg_unit(C, args, layer, (u - 1024) >> 2, (u - 1024) & 3);
                else cc_unit(C, args, layer, grp, u - 1536);
            }
            grid.sync();
#pragma unroll 1
            for (int u = C.bid; u < 1024; u += C.G) rg_unit<2>(C, args, layer, grp, u >> 3, u & 7);
            grid.sync(); }
#ifdef REP_P2B
#pragma unroll 1
            for (int u = C.bid; u < 1024; u += C.G) rg_unit<2>(C, args, layer, grp, u >> 3, u & 7);
            grid.sync();
#endif
            { pg8::EpiMerge E0{PROJ + OFF_GATE, DIN, MACC, MERGED, 0};
              run_gemm(C, BA, (const bf16_t*)(wl + LW_WBA), TG, D, D, E0);
              pg8::EpiMerge E1{PROJ + OFF_GATE + 1024, DIN, MACC, MERGED, 1};
              run_gemm(C, BB, (const bf16_t*)(wl + LW_WBB), TG, D, 512, E1);
              pg8::EpiMerge E2{PROJ + OFF_GATE + 2048, DIN, MACC, MERGED, 2};
              run_gemm(C, BC, (const bf16_t*)(wl + LW_WBC), TG, D, 512, E2); }
            grid.sync();
            { pg8::EpiResid E{X, args.in[25] + (size_t)layer * D, ALPHA};
              run_gemm(C, MERGED, (const bf16_t*)(wl + LW_WO), TG, D, D, E); }
            grid.sync();
            ln_rows(C, X, X, XB, args.in[26] + (size_t)layer * D, args.in[27] + (size_t)layer * D, TG);
            grid.sync();
#pragma unroll 1
            for (int rep = 0; rep < REP_P5; ++rep) {
            { pg8::EpiAct E{HID, DFF, args.in[29] + (size_t)layer * DFF, 1};
              run_gemm(C, XB, (const bf16_t*)(wl + LW_FF1), TG, DFF, D, E); }
            grid.sync(); }
            { pg8::EpiResid E{X, args.in[31] + (size_t)layer * D, ALPHA};
              run_gemm(C, HID, (const bf16_t*)(wl + LW_FF2), TG, D, DFF, E); }
            grid.sync();
            const bool last = (layer == DEPTH - 1);
            ln_rows(C, X, X, last ? (bf16_t*)nullptr : XB, args.in[32] + (size_t)layer * D, args.in[33] + (size_t)layer * D, TG);
            if (last && grp + 1 < NGRP)
                ln_rows(C, args.in[1] + (size_t)grp * TG * D, C.out + (size_t)(grp + 1) * TG * D, XB, args.in[2], args.in[3], TG);
            grid.sync();
        }
    }
}

extern "C" void kernel_launch(void* const* d_in, const int* in_sizes, int n_in, void* d_out, int out_size, void* d_ws, size_t ws_size, hipStream_t stream) {
    static int grid = 0;
    if (grid == 0) {
        if (n_in != 34 || ws_size < WS_END) { fprintf(stderr, "kernel_launch: unexpected n_in %d / ws_size %zu (need %zu)\n", n_in, ws_size, (size_t)WS_END); grid = -1; return; }
        int dev = 0, cus = 0, per_cu = 0;
        hipGetDevice(&dev);
        hipDeviceGetAttribute(&cus, hipDeviceAttributeMultiprocessorCount, dev);
        hipFuncSetAttribute((const void*)fwd_kernel, hipFuncAttributeMaxDynamicSharedMemorySize, LDS_BYTES);
        hipOccupancyMaxActiveBlocksPerMultiprocessor(&per_cu, (const void*)fwd_kernel, NT, LDS_BYTES);
        if (per_cu < 1) per_cu = 1;
        grid = cus * per_cu;
        (void)hipGetLastError();
    }
    if (grid < 0) return;
    Args a{};
    for (int i = 0; i < 34; ++i) a.in[i] = (const float*)d_in[i];
    a.out = (float*)d_out; a.ws = (unsigned char*)d_ws;
    void* kargs[] = {&a};
    hipError_t e = hipLaunchCooperativeKernel((const void*)fwd_kernel, dim3(grid), dim3(NT), kargs, LDS_BYTES, stream);
    if (e != hipSuccess) fprintf(stderr, "cooperative launch failed: %s (grid %d)\n", hipGetErrorString(e), grid);
}

#ifdef TESTK
#define MKCTX extern __shared__ __attribute__((aligned(16))) unsigned char shm[]; Ctx C; C.out = args.out; C.ws = args.ws; C.lds = (LAS unsigned char*)shm; \
    C.tid = threadIdx.x; C.lane = C.tid & 63; C.wave = __builtin_amdgcn_readfirstlane(C.tid >> 6); C.G = gridDim.x; C.bid = blockIdx.x;
__global__ void __launch_bounds__(NT, 2) t_prol(Args args) { MKCTX prologue_weights(C, args); ln_rows(C, args.in[0], C.out, (bf16_t*)(C.ws + WS_XB), args.in[2], args.in[3], TG); }
__global__ void __launch_bounds__(NT, 2) t_rg1(Args args, int layer, int grp) { MKCTX for (int u = C.bid; u < 1024; u += C.G) rg_unit<1>(C, args, layer, grp, u >> 3, u & 7); }
__global__ void __launch_bounds__(NT, 2) t_rg2(Args args, int layer, int grp) { MKCTX for (int u = C.bid; u < 1024; u += C.G) rg_unit<2>(C, args, layer, grp, u >> 3, u & 7); }
__global__ void __launch_bounds__(NT, 2) t_sg(Args args, int layer, int grp) { MKCTX for (int u = C.bid; u < 512; u += C.G) sg_unit(C, args, layer, u >> 2, u & 3); }
__global__ void __launch_bounds__(NT, 2) t_cc(Args args, int layer, int grp) { MKCTX for (int u = C.bid; u < 256; u += C.G) cc_unit(C, args, layer, grp, u); }
__global__ void __launch_bounds__(NT, 2) t_g1(Args args, int layer) { MKCTX pg8::EpiAct E{(bf16_t*)(C.ws + WS_PROJ), DIN, args.in[5] + (size_t)layer * DIN, 0}; run_gemm(C, (bf16_t*)(C.ws + WS_XB), (const bf16_t*)(C.ws), TG, DIN, D, E); }
__global__ void __launch_bounds__(NT, 2) t_g3(Args args, int layer, int mode) { MKCTX pg8::EpiMerge E{(bf16_t*)(C.ws + WS_PROJ), DIN, (float*)(C.ws + WS_MACC), (bf16_t*)(C.ws + WS_XB), mode}; run_gemm(C, (bf16_t*)(C.ws + WS_BA), (const bf16_t*)(C.ws), TG, D, D, E); }
__global__ void __launch_bounds__(NT, 2) t_g4(Args args, int layer) { MKCTX pg8::EpiResid E{C.out, args.in[25] + (size_t)layer * D, ALPHA}; run_gemm(C, (bf16_t*)(C.ws + WS_XB), (const bf16_t*)(C.ws), TG, D, D, E); }
#endif
```
